# Optimizing an MI355X kernel written in HIP

```python
import numpy as np
import jax, jax.numpy as jnp
from jax import lax

D_MODEL = 1024
BATCH = 32
SEQ = 2048
DEPTH = 4

GRID_W = 64
CTX_LEN = 256
N_EVEN = (DEPTH + 1) // 2
N_ODD = DEPTH // 2

GLA_HEADS = 4
GLA_DK = D_MODEL // 16
GLA_DV = D_MODEL // 8
GLA_QK = GLA_HEADS * GLA_DK
GLA_V = GLA_HEADS * GLA_DV
GLA_RANK = 16
GLA_TAU = 16.0
GLA_CHUNK = 64
GLA_SIZES = (GLA_QK, GLA_QK, GLA_V, GLA_V, GLA_RANK, GLA_RANK)
GLA_IN = sum(GLA_SIZES)

RW_HEADS = 8
RW_DH = D_MODEL // 16
RW_W = RW_HEADS * RW_DH
RW_DECAY_RANK = 32
RW_A_RANK = 32
RW_G_RANK = 96
RW_GN_EPS = 64e-5
RW_SIZES = (RW_W, RW_W, RW_W, RW_DECAY_RANK, RW_DECAY_RANK, RW_A_RANK, RW_G_RANK)
RW_IN = sum(RW_SIZES)
EVEN_IN = GLA_IN + RW_IN
EVEN_MIX = GLA_V + RW_W

HEAD_DIM = 64
C_HEADS = 8
C_KV = 2
Q_BLOCK = 128
ROPE_THETA = 10000.0
NA_HEADS = 8
NA_KH = 8
NA_KW = 16
ODD_SIZES = (C_HEADS * HEAD_DIM, C_KV * HEAD_DIM, C_KV * HEAD_DIM,
             NA_HEADS * HEAD_DIM, NA_HEADS * HEAD_DIM, NA_HEADS * HEAD_DIM)
ODD_IN = sum(ODD_SIZES)
ODD_MIX = (C_HEADS + NA_HEADS) * HEAD_DIM

D_FF = -(-8 * D_MODEL // (3 * 256)) * 256

kernel_name = "hybrid_gla_rwkv7_gqa_natten_dit"

F32 = jnp.float32


def _split(z, sizes):
    return jnp.split(z, [int(i) for i in np.cumsum(sizes)[:-1]], axis=-1)


def rmsnorm(x, g, eps=1e-6):
    xf = x.astype(F32)
    y = xf * lax.rsqrt(jnp.mean(xf * xf, axis=-1, keepdims=True) + eps)
    return (y * g.astype(F32)).astype(x.dtype)


def swiglu(h, w13, w2):
    a, b = jnp.split(h @ w13, 2, axis=-1)
    return (jax.nn.silu(a) * b) @ w2


def token_shift(p, mu_prev, mu_next):
    prev = jnp.pad(p, ((0, 0), (1, 0), (0, 0)))[:, :-1]
    nxt = jnp.pad(p, ((0, 0), (0, 1), (0, 0)))[:, 1:]
    return p + mu_prev * (prev - p) + mu_next * (nxt - p)


def gla_chunked(q, k, v, log_a, s0):
    B, T, H, DK = q.shape
    DV = v.shape[-1]
    L = GLA_CHUNK
    n = T // L
    qf = q.astype(F32).reshape(B, n, L, H, DK)
    kf = k.astype(F32).reshape(B, n, L, H, DK)
    vf = v.astype(F32).reshape(B, n, L, H, DV)
    b = jnp.cumsum(log_a.astype(F32).reshape(B, n, L, H, DK), axis=2)
    total = b[:, :, -1]
    qb = qf * jnp.exp(b)
    kb = kf * jnp.exp(-b)
    lower = jnp.tril(jnp.ones((L, L), dtype=bool))
    att = jnp.where(lower, jnp.einsum('bnihd,bnjhd->bnhij', qb, kb), 0.0)
    o = jnp.einsum('bnhij,bnjhv->bnihv', att, vf)
    u = jnp.einsum('bnjhd,bnjhv->bnhdv', kf * jnp.exp(total[:, :, None] - b), vf)

    def step(s, inp):
        dec, uc = inp
        return dec[..., None] * s + uc, s

    s_fin, s_prev = lax.scan(step, s0, (jnp.exp(total).transpose(1, 0, 2, 3), u.transpose(1, 0, 2, 3, 4)))
    o = o + jnp.einsum('bnihd,nbhdv->bnihv', qb, s_prev)
    return o.reshape(B, T, H, DV).astype(v.dtype), s_fin


def rwkv7_scan(r, w, k, v, a, b, s0):
    xs = tuple(t.astype(F32).transpose(1, 0, 2, 3) for t in (r, w, k, v, a, b))

    def step(s, inp):
        rt, wt, kt, vt, at, bt = inp
        sa = jnp.einsum('bhvk,bhk->bhv', s, at)
        s = s * wt[:, :, None, :] + sa[..., None] * bt[:, :, None, :] + vt[..., None] * kt[:, :, None, :]
        return s, jnp.einsum('bhvk,bhk->bhv', s, rt)

    s_fin, o = lax.scan(step, s0, xs)
    return o.transpose(1, 0, 2, 3).astype(v.dtype), s_fin


def bidir(fn, fwd_in, bwd_in, s0_f, s0_b):
    o_f, s_f = fn(*fwd_in, s0_f)
    o_b, s_b = fn(*[jnp.flip(t, axis=1) for t in bwd_in], s0_b)
    return o_f + jnp.flip(o_b, axis=1), s_f, s_b


def gla_features(z, a_up, a_bias):
    B, T = z.shape[:2]
    q, k, v, g, ad_f, ad_b = _split(z, GLA_SIZES)
    la = [(jax.nn.log_sigmoid((ad @ a_up[d] + a_bias[d]).astype(F32)) / GLA_TAU).reshape(B, T, GLA_HEADS, GLA_DK)
          for d, ad in enumerate((ad_f, ad_b))]
    return (q.reshape(B, T, GLA_HEADS, GLA_DK) * GLA_DK ** -0.5, k.reshape(B, T, GLA_HEADS, GLA_DK),
            v.reshape(B, T, GLA_HEADS, GLA_DV), g, la[0], la[1])


def rwkv_features(z, mu, w0, w_up, a0, a_up, g_up, k_k, k_a):
    B, T = z.shape[:2]
    z = token_shift(z, mu[0], mu[1])
    r, k, v, wd_f, wd_b, ad, gd = _split(z, RW_SIZES)
    hd = lambda t: t.reshape(B, T, RW_HEADS, RW_DH)
    decays = []
    for d, wd in enumerate((wd_f, wd_b)):
        wl = -jax.nn.softplus(-(w0[d] + jnp.tanh(wd) @ w_up[d]).astype(F32)) - 0.5
        decays.append(hd(jnp.exp(-jnp.exp(wl))))
    a = jax.nn.sigmoid(a0 + ad @ a_up)
    g = jax.nn.sigmoid(gd) @ g_up
    kk = hd(k * k_k).astype(F32)
    kk = kk / jnp.maximum(jnp.sqrt(jnp.sum(kk * kk, axis=-1, keepdims=True)), 1e-12)
    k = k * (1 + (a - 1) * k_a)
    return hd(r), decays[0], decays[1], hd(k), hd(v), -kk, kk * hd(a).astype(F32), g


def even_mixer(h, hc, w_in, w_out, a_up, a_bias, gla_g, mu, w0, w_up, a0, aa_up, g_up,
               k_k, k_a, r_k, ln_g, ln_b, need_ctx):
    def features(hh):
        z = hh @ w_in
        return (gla_features(z[..., :GLA_IN], a_up, a_bias),
                rwkv_features(z[..., GLA_IN:], mu, w0, w_up, a0, aa_up, g_up, k_k, k_a))

    gla_c, rw_c = features(hc)
    gla_x, rw_x = features(h)
    B = h.shape[0]
    s0_gla = jnp.zeros((B, GLA_HEADS, GLA_DK, GLA_DV), F32)
    s0_rw = jnp.zeros((B, RW_HEADS, RW_DH, RW_DH), F32)

    def run_gla(f, s_f, s_b):
        q, k, v, _, la_f, la_b = f
        return bidir(gla_chunked, (q, k, v, la_f), (q, k, v, la_b), s_f, s_b)

    def run_rw(f, s_f, s_b):
        r, wf, wb, k, v, av, bv, _ = f
        return bidir(rwkv7_scan, (r, wf, k, v, av, bv), (r, wb, k, v, av, bv), s_f, s_b)

    og_c, sg_f, sg_b = run_gla(gla_c, s0_gla, s0_gla)
    or_c, sr_f, sr_b = run_rw(rw_c, s0_rw, s0_rw)
    og_x, _, _ = run_gla(gla_x, sg_f, sg_b)
    or_x, _, _ = run_rw(rw_x, sr_f, sr_b)

    def merge(og, gf, orw, rf):
        Bm, T = og.shape[:2]
        r, _, _, k, v, _, _, g_rw = rf
        y_gla = rmsnorm(og, gla_g) * jax.nn.silu(gf[3]).reshape(Bm, T, GLA_HEADS, GLA_DV)
        of = orw.astype(F32)
        mean = jnp.mean(of, axis=-1, keepdims=True)
        var = jnp.mean(jnp.square(of - mean), axis=-1, keepdims=True)
        y_rw = ((of - mean) * lax.rsqrt(var + RW_GN_EPS)).astype(orw.dtype).reshape(Bm, T, RW_W) * ln_g + ln_b
        bonus = jnp.sum(r * k * r_k, axis=-1, keepdims=True) * v
        y_rw = (y_rw + bonus.reshape(Bm, T, RW_W)) * g_rw
        return jnp.concatenate([y_gla.reshape(Bm, T, GLA_V), y_rw], axis=-1) @ w_out

    y = merge(og_x, gla_x, or_x, rw_x)
    yc = merge(og_c, gla_c, or_c, rw_c) if need_ctx else None
    return y, yc


def axial_rope_tables(T):
    t = jnp.arange(T)
    pos = jnp.stack([t // GRID_W, t % GRID_W], axis=-1).astype(F32)
    half = HEAD_DIM // 2
    inv = ROPE_THETA ** (-jnp.arange(0, half, 2, dtype=F32) / half)
    ang = pos[:, :, None] * inv
    return jnp.cos(ang), jnp.sin(ang)


def apply_rope(x, cos, sin):
    B, T, H, dh = x.shape
    xf = x.astype(F32).reshape(B, T, H, 2, 2, dh // 4)
    x1, x2 = xf[..., 0, :], xf[..., 1, :]
    c, s = cos[None, :, None], sin[None, :, None]
    out = jnp.stack([x1 * c - x2 * s, x1 * s + x2 * c], axis=-2)
    return out.reshape(B, T, H, dh).astype(x.dtype)


def blocked_attention(q, k, v):
    B, T, Hq, dh = q.shape
    Hkv = k.shape[2]
    G = Hq // Hkv
    nb = T // Q_BLOCK
    qb = (q * dh ** -0.5).reshape(B, nb, Q_BLOCK, Hkv, G, dh).transpose(1, 0, 2, 3, 4, 5)

    def blk(qi):
        s = jnp.einsum('bqkgd,bskd->bkgqs', qi, k).astype(F32)
        p = jax.nn.softmax(s, axis=-1).astype(v.dtype)
        return jnp.einsum('bkgqs,bskd->bqkgd', p, v)

    o = lax.map(blk, qb)
    return o.transpose(1, 0, 2, 3, 4, 5).reshape(B, T, Hq * dh)


def neighbourhood_attention(q, k, v, k_ctx, v_ctx, rpb):
    B, T, H, dh = q.shape
    rows = T // GRID_W
    kh = min(NA_KH, rows)
    kw = min(NA_KW, GRID_W)
    qr = (q * dh ** -0.5).reshape(B, rows, GRID_W, H, dh).transpose(1, 0, 2, 3, 4)
    kg = k.reshape(B, rows, GRID_W, H, dh)
    vg = v.reshape(B, rows, GRID_W, H, dh)
    col = jnp.arange(GRID_W)
    start = jnp.clip(col - kw // 2, 0, GRID_W - kw)
    in_win = (col[None, :] >= start[:, None]) & (col[None, :] < start[:, None] + kw)
    dc = jnp.clip(col[None, :] - col[:, None], -(NA_KW - 1), NA_KW - 1) + NA_KW - 1
    bias_cols = rpb[:, :, dc]

    def row(args):
        r, q_r = args
        rs = jnp.clip(r - kh // 2, 0, rows - kh)
        k_r = lax.dynamic_slice_in_dim(kg, rs, kh, axis=1)
        v_r = lax.dynamic_slice_in_dim(vg, rs, kh, axis=1)
        bias = bias_cols[:, rs + jnp.arange(kh) - r + NA_KH - 1]
        s_nb = jnp.einsum('bchd,bkwhd->bhckw', q_r, k_r).astype(F32) + bias.transpose(0, 2, 1, 3)[None].astype(F32)
        s_nb = jnp.where(in_win[:, None, :], s_nb, -jnp.inf)
        s_cx = jnp.einsum('bchd,blhd->bhcl', q_r, k_ctx).astype(F32)
        p = jax.nn.softmax(jnp.concatenate([s_nb.reshape(B, H, GRID_W, kh * GRID_W), s_cx], axis=-1), axis=-1)
        p = p.astype(v.dtype)
        p_nb = p[..., :kh * GRID_W].reshape(B, H, GRID_W, kh, GRID_W)
        return (jnp.einsum('bhckw,bkwhd->bchd', p_nb, v_r)
                + jnp.einsum('bhcl,blhd->bchd', p[..., kh * GRID_W:], v_ctx))

    o = lax.map(row, (jnp.arange(rows), qr))
    return o.transpose(1, 0, 2, 3, 4).reshape(B, T, H * dh)


def odd_mixer(h, hc, w_in, w_out, q_g, k_g, rpb, cos, sin, need_ctx):
    def features(hh):
        B, T = hh.shape[:2]
        qc, kc, vc, qd, kd, vd = _split(hh @ w_in, ODD_SIZES)
        return (rmsnorm(qc.reshape(B, T, C_HEADS, HEAD_DIM), q_g),
                rmsnorm(kc.reshape(B, T, C_KV, HEAD_DIM), k_g),
                vc.reshape(B, T, C_KV, HEAD_DIM),
                qd.reshape(B, T, NA_HEADS, HEAD_DIM),
                kd.reshape(B, T, NA_HEADS, HEAD_DIM),
                vd.reshape(B, T, NA_HEADS, HEAD_DIM))

    qc_c, kc_c, vc_c, qd_c, kd_c, vd_c = features(hc)
    qc, kc, vc, qd, kd, vd = features(h)
    qc, kc = apply_rope(qc, cos, sin), apply_rope(kc, cos, sin)
    y_gqa = blocked_attention(qc, jnp.concatenate([kc_c, kc], axis=1), jnp.concatenate([vc_c, vc], axis=1))
    y_na = neighbourhood_attention(qd, kd, vd, kd_c, vd_c, rpb)
    y = jnp.concatenate([y_gqa, y_na], axis=-1) @ w_out
    yc = None
    if need_ctx:
        yc = jnp.concatenate([blocked_attention(qc_c, kc_c, vc_c), blocked_attention(qd_c, kd_c, vd_c)], axis=-1) @ w_out
    return y, yc


def setup_inputs(seed: int = 0) -> dict:
    key = jax.random.key(seed)
    ks = iter(jax.random.split(key, 40))
    nrm = lambda shape, s: jax.random.normal(next(ks), shape, F32) * s
    uni = lambda shape, lo, hi: jax.random.uniform(next(ks), shape, F32, lo, hi)
    D = D_MODEL
    return {
        "x": nrm((BATCH, SEQ, D), 1.0),
        "c": nrm((BATCH, D), 1.0),
        "ctx": nrm((BATCH, CTX_LEN, D), 1.0),
        "c_ctx": nrm((D,), 1.0),
        "w_mod": nrm((DEPTH, D, 6 * D), 0.02),
        "b_mod": nrm((DEPTH, 6 * D), 0.02),
        "norm1_g": 1.0 + nrm((DEPTH, D), 0.02),
        "norm2_g": 1.0 + nrm((DEPTH, D), 0.02),
        "ffn_w13": nrm((DEPTH, D, 2 * D_FF), D ** -0.5),
        "ffn_w2": nrm((DEPTH, D_FF, D), D_FF ** -0.5),
        "ev_w_in": nrm((N_EVEN, D, EVEN_IN), D ** -0.5),
        "ev_w_out": nrm((N_EVEN, EVEN_MIX, D), EVEN_MIX ** -0.5),
        "gla_a_up": nrm((N_EVEN, 2, GLA_RANK, GLA_QK), GLA_RANK ** -0.5),
        "gla_a_bias": uni((N_EVEN, 2, GLA_QK), 1.0, 4.0),
        "gla_norm_g": 1.0 + nrm((N_EVEN, GLA_DV), 0.02),
        "rw_mu": uni((N_EVEN, 2, RW_IN), 0.0, 0.5),
        "rw_w0": uni((N_EVEN, 2, RW_W), -6.0, -1.0),
        "rw_w_up": nrm((N_EVEN, 2, RW_DECAY_RANK, RW_W), 0.5 * RW_DECAY_RANK ** -0.5),
        "rw_a0": nrm((N_EVEN, RW_W), 0.1),
        "rw_a_up": nrm((N_EVEN, RW_A_RANK, RW_W), 0.5 * RW_A_RANK ** -0.5),
        "rw_g_up": nrm((N_EVEN, RW_G_RANK, RW_W), RW_G_RANK ** -0.5),
        "rw_k_k": 0.85 + nrm((N_EVEN, RW_W), 0.02),
        "rw_k_a": 1.0 + nrm((N_EVEN, RW_W), 0.02),
        "rw_r_k": nrm((N_EVEN, RW_HEADS, RW_DH), 0.1),
        "rw_ln_g": 1.0 + nrm((N_EVEN, RW_W), 0.02),
        "rw_ln_b": nrm((N_EVEN, RW_W), 0.02),
        "od_w_in": nrm((N_ODD, D, ODD_IN), D ** -0.5),
        "od_w_out": nrm((N_ODD, ODD_MIX, D), ODD_MIX ** -0.5),
        "cq_norm_g": 1.0 + nrm((N_ODD, HEAD_DIM), 0.02),
        "ck_norm_g": 1.0 + nrm((N_ODD, HEAD_DIM), 0.02),
        "na_rpb": nrm((N_ODD, NA_HEADS, 2 * NA_KH - 1, 2 * NA_KW - 1), 0.1),
        "final_g": 1.0 + nrm((D,), 0.02),
    }


def reference(x, c, ctx, c_ctx, w_mod, b_mod, norm1_g, norm2_g, ffn_w13, ffn_w2,
              ev_w_in, ev_w_out, gla_a_up, gla_a_bias, gla_norm_g, rw_mu, rw_w0, rw_w_up,
              rw_a0, rw_a_up, rw_g_up, rw_k_k, rw_k_a, rw_r_k, rw_ln_g, rw_ln_b,
              od_w_in, od_w_out, cq_norm_g, ck_norm_g, na_rpb, final_g):
    cos, sin = axial_rope_tables(x.shape[1])
    s_lat = jax.nn.silu(c)
    s_ctx = jax.nn.silu(c_ctx)
    for i in range(DEPTH):
        need_ctx = i < DEPTH - 1
        sh1, sc1, g1, sh2, sc2, g2 = [m[:, None, :] for m in _split(s_lat @ w_mod[i] + b_mod[i], [D_MODEL] * 6)]
        sh1c, sc1c, g1c, sh2c, sc2c, g2c = _split(s_ctx @ w_mod[i] + b_mod[i], [D_MODEL] * 6)
        h = rmsnorm(x, norm1_g[i]) * (1 + sc1) + sh1
        hc = rmsnorm(ctx, norm1_g[i]) * (1 + sc1c) + sh1c
        j = i // 2
        if i % 2 == 0:
            y, yc = even_mixer(h, hc, ev_w_in[j], ev_w_out[j], gla_a_up[j], gla_a_bias[j], gla_norm_g[j],
                               rw_mu[j], rw_w0[j], rw_w_up[j], rw_a0[j], rw_a_up[j], rw_g_up[j],
                               rw_k_k[j], rw_k_a[j], rw_r_k[j], rw_ln_g[j], rw_ln_b[j], need_ctx)
        else:
            y, yc = odd_mixer(h, hc, od_w_in[j], od_w_out[j], cq_norm_g[j], ck_norm_g[j], na_rpb[j],
                              cos, sin, need_ctx)
        x = x + g1 * y
        h = rmsnorm(x, norm2_g[i]) * (1 + sc2) + sh2
        x = x + g2 * swiglu(h, ffn_w13[i], ffn_w2[i])
        if need_ctx:
            ctx = ctx + g1c * yc
            hc = rmsnorm(ctx, norm2_g[i]) * (1 + sc2c) + sh2c
            ctx = ctx + g2c * swiglu(hc, ffn_w13[i], ffn_w2[i])
    return rmsnorm(x, final_g)
```

```cpp
#include <hip/hip_runtime.h>
#include <hip/hip_cooperative_groups.h>
#include <cstdio>
namespace cg = cooperative_groups;

#define LAS __attribute__((address_space(3)))
typedef unsigned short bf16_t;
typedef short bf16x8 __attribute__((ext_vector_type(8)));
typedef float f32x4 __attribute__((ext_vector_type(4)));
typedef float f32x2 __attribute__((ext_vector_type(2)));
typedef unsigned u32x4 __attribute__((ext_vector_type(4)));
typedef unsigned u32x2 __attribute__((ext_vector_type(2)));

constexpr int D = 1024, NB = 32, TL = 2048, CL = 256, TT = 2304, MROWS = NB * TT, HROWS = MROWS / 2;
constexpr int EV_IN = 3296, EV_INP = 3328, OD_IN = 2304, DFF = 2816, NFF = 5632;
constexpr int LDS_BYTES = 144 * 1024;
#ifndef REP_ATTN
#define REP_ATTN 1
#endif
#ifndef REP_RWKV
#define REP_RWKV 1
#endif
#ifndef REP_GLA
#define REP_GLA 1
#endif
#ifndef REP_FEAT
#define REP_FEAT 1
#endif
#ifndef REP_FFNUP
#define REP_FFNUP 1
#endif
constexpr size_t OFF_CTXX = 0, OFF_MOD = 33554432, OFF_W = 37748736, WL_BYTES = 26214400, OFF_H = 142606336, OFF_R = 293601280;
constexpr size_t WO_IN = 0, WO_OUT = 6815744, WO_W13 = 8912896, WO_W2 = 20447232;
constexpr size_t RO_F = 245366784, RO_O = 547356672;
constexpr size_t RO_VTG = 339738624, RO_VTN = 358612992;
constexpr size_t WS_NEED = OFF_R + 698351616;

struct Params { const float* in[32]; float* out; unsigned char* ws; };
typedef const __attribute__((address_space(4))) char* kaptr_t;
__device__ __forceinline__ kaptr_t kabase() { kaptr_t ka = (kaptr_t)__builtin_amdgcn_kernarg_segment_ptr(); asm volatile("" : "+s"(ka)); return ka; }
__device__ __forceinline__ const float* inp(int i) { return *(const float* const __attribute__((address_space(4)))*)(kabase() + 8 * i); }
__device__ __forceinline__ float* outp() { return *(float* const __attribute__((address_space(4)))*)(kabase() + 256); }
__device__ __forceinline__ unsigned char* wsp() { return *(unsigned char* const __attribute__((address_space(4)))*)(kabase() + 264); }

typedef float cvt_f32x2_t __attribute__((ext_vector_type(2)));
typedef __bf16 cvt_bf16x2_t __attribute__((ext_vector_type(2)));
__device__ __forceinline__ unsigned pk2(float lo, float hi) { const cvt_f32x2_t v = {lo, hi}; const cvt_bf16x2_t b = __builtin_convertvector(v, cvt_bf16x2_t); return __builtin_bit_cast(unsigned, b); }
__device__ __forceinline__ unsigned f2bf(float f) { return pk2(f, f) & 0xffffu; }
__device__ __forceinline__ float bflo(unsigned u) { return __builtin_bit_cast(float, u << 16); }
__device__ __forceinline__ float bfhi(unsigned u) { return __builtin_bit_cast(float, u & 0xffff0000u); }
__device__ __forceinline__ float bf1(bf16_t b) { return __builtin_bit_cast(float, ((unsigned)b) << 16); }
__device__ __forceinline__ void unpack8(u32x4 w, float* o) { o[0] = bflo(w.x); o[1] = bfhi(w.x); o[2] = bflo(w.y); o[3] = bfhi(w.y); o[4] = bflo(w.z); o[5] = bfhi(w.z); o[6] = bflo(w.w); o[7] = bfhi(w.w); }
__device__ __forceinline__ u32x4 pack8(const float* v) { u32x4 w; w.x = pk2(v[0], v[1]); w.y = pk2(v[2], v[3]); w.z = pk2(v[4], v[5]); w.w = pk2(v[6], v[7]); return w; }
__device__ __forceinline__ int tid_() { int t = threadIdx.x; asm volatile("" : "+v"(t)); return t; }
__device__ __forceinline__ int bid_() { int t = blockIdx.x; asm volatile("" : "+s"(t)); return t; }
__device__ __forceinline__ int gdim_() { int t = gridDim.x; asm volatile("" : "+s"(t)); return t; }
__device__ __forceinline__ float sigmoidf_(float x) { return __builtin_amdgcn_rcpf(1.0f + __expf(-x)); }
__device__ __forceinline__ float siluf_(float x) { return x * __builtin_amdgcn_rcpf(1.0f + __expf(-x)); }
template <int CTRL> __device__ __forceinline__ float dppf(float x) { return __builtin_bit_cast(float, __builtin_amdgcn_mov_dpp(__builtin_bit_cast(int, x), CTRL, 0xf, 0xf, true)); }
__device__ __forceinline__ float red8(float x) { x += dppf<0xB1>(x); x += dppf<0x4E>(x); x += dppf<0x141>(x); return x; }
__device__ __forceinline__ int x32addr_() { int l = __builtin_amdgcn_mbcnt_hi(-1, __builtin_amdgcn_mbcnt_lo(-1, 0)); asm volatile("" : "+v"(l)); return (l ^ 32) << 2; }
__device__ __forceinline__ float shx2(float x) { return dppf<0x4E>(x); }
__device__ __forceinline__ float shx8(float x) { return dppf<0x128>(x); }
__device__ __forceinline__ float shx16(float x) { return __builtin_bit_cast(float, __builtin_amdgcn_ds_swizzle(__builtin_bit_cast(int, x), 0x401F)); }
__device__ __forceinline__ float shx32(float x, int a32) { return __builtin_bit_cast(float, __builtin_amdgcn_ds_bpermute(a32, __builtin_bit_cast(int, x))); }
__device__ __forceinline__ float red16(float x) { x = red8(x); x += shx8(x); return x; }
__device__ __forceinline__ float red64(float x, int a32) { x = red16(x); x += shx16(x); x += shx32(x, a32); return x; }

namespace pg8 {
constexpr int BM = 256, BK = 64, HALF = 128, HTB = HALF * BK * 2, STAGE_BYTES = 8 * HTB, NXCD = 8, WGM = 8;
__device__ __forceinline__ int lds_byte(int r, int c) { const int st = (r >> 4) * 2 + (c >> 5), rr = r & 15, cc = c & 31, ob = rr * 64 + cc * 2; return st * 1024 + (ob ^ (((ob >> 9) & 1) << 5)); }
__device__ __forceinline__ void stage_rc(int b, int& R, int& C) { const int st = b / 1024, sb = b % 1024, swz = sb ^ (((sb >> 9) & 1) << 5); R = (st >> 1) * 16 + swz / 64; C = (st & 1) * 32 + (swz % 64) / 2; }
__device__ __forceinline__ int perm32(int rho) { const int n = rho >> 4, i = rho & 15; return 8 * (i >> 2) + 4 * n + (i & 3); }
struct Unit { int pm, pn; };
struct Gemm { const bf16_t* A; const bf16_t* Bt; int M, N, K; };
struct StaticOrder {
    int nM, nN, nwg, G, c, skip;
    __device__ void init(int M, int N, int G_, int c_, int skip_ = 0) { skip = skip_; nM = skip_ ? NB * 8 : M / BM; nN = N / BM; nwg = nM * nN; G = G_; c = c_; }
    __device__ bool next(int i, Unit& u) const {
        const long L = (long)i * G + c; if (L >= nwg) return false;
        int wgid = (int)L; { const int q = nwg / NXCD, r = nwg % NXCD, xcd = wgid % NXCD, off = wgid / NXCD; wgid = (xcd < r ? xcd * (q + 1) : r * (q + 1) + (xcd - r) * q) + off; }
        const int nig = WGM * nN, gid = wgid / nig, fm = gid * WGM, gsz = (nM - fm) < WGM ? (nM - fm) : WGM;
        u.pm = fm + ((wgid % nig) % gsz); u.pn = (wgid % nig) / gsz; if (skip) u.pm = (u.pm >> 3) * 9 + 1 + (u.pm & 7); return true;
    }
};
template <class Epi>
__device__ __forceinline__ void gemm_phase(LAS unsigned char* lds, const Gemm g, const StaticOrder& S, const Epi& E) {
    const int tid = tid_(), wid = __builtin_amdgcn_readfirstlane(tid >> 6), lane = tid & 63, wr = wid >> 2, wc = wid & 3, fr = lane & 15, fq = lane >> 4;
    const int K = g.K, nt = K / BK;
    unsigned voffA[2], voffB[2];
#pragma unroll
    for (int i = 0; i < 2; ++i) { int R, C; stage_rc(tid * 16 + i * 8192, R, C); const int Rb = Epi::PERM ? ((R & ~31) + perm32(R & 31)) : R;
        voffA[i] = (unsigned)(R * K + C) * 2u; voffB[i] = (unsigned)(Rb * K + C) * 2u; }
    const size_t kstep = (size_t)(BK * 2);
    const size_t hstep = (size_t)HALF * K * 2;
    const size_t tstep = 2 * hstep;
    const unsigned ldsw = (unsigned)wid * 1024u;
    const int aoff = lds_byte(wr * 64 + fr, fq * 8), boff = lds_byte(wc * 32 + fr, fq * 8);
#define PG8_SA(b, h) (((b) * 2 + (h)) * HTB)
#define PG8_SB(b, h) ((4 + (b) * 2 + (h)) * HTB)
#define PG8_STAGE(bufoff, gbase, voff) do { _Pragma("unroll") for (int _i = 0; _i < 2; ++_i) \
        __builtin_amdgcn_global_load_lds((const unsigned*)((const char*)(gbase) + (voff)[_i]), (LAS unsigned*)(lds + (bufoff) + ldsw + _i * 8192), 16, 0, 0); } while (0)
#define PG8_LDA(dst, b, h) do { _Pragma("unroll") for (int m = 0; m < 4; ++m) _Pragma("unroll") for (int k = 0; k < 2; ++k) dst[m][k] = *(const LAS bf16x8*)(lds + PG8_SA(b, h) + aoff + m * 2048 + k * 1024); } while (0)
#define PG8_LDB(dst, b, h) do { _Pragma("unroll") for (int n = 0; n < 2; ++n) _Pragma("unroll") for (int k = 0; k < 2; ++k) dst[n][k] = *(const LAS bf16x8*)(lds + PG8_SB(b, h) + boff + n * 2048 + k * 1024); } while (0)
#define PG8_MMA(ai, bj, At, Bt) do { __builtin_amdgcn_s_setprio(1); _Pragma("unroll") for (int m = 0; m < 4; ++m) _Pragma("unroll") for (int n = 0; n < 2; ++n) _Pragma("unroll") for (int k = 0; k < 2; ++k) \
        acc[ai][bj][m][n] = __builtin_amdgcn_mfma_f32_16x16x32_bf16(Bt[n][k], At[m][k], acc[ai][bj][m][n], 0, 0, 0); __builtin_amdgcn_s_setprio(0); } while (0)
#define PG8_WAIT_V(n) asm volatile("s_waitcnt vmcnt(" #n ")" ::: "memory")
#define PG8_WAIT_L(n) asm volatile("s_waitcnt lgkmcnt(" #n ")" ::: "memory")
#define PG8_BAR __builtin_amdgcn_s_barrier()
#define PG8_SCHED __builtin_amdgcn_sched_barrier(0)
    Unit cur, nxt; int ui = 0;
    if (!S.next(0, cur)) return;
    f32x4 acc[2][2][4][2];
#pragma unroll
    for (int a = 0; a < 2; ++a)
#pragma unroll
        for (int b = 0; b < 2; ++b)
#pragma unroll
            for (int m = 0; m < 4; ++m)
#pragma unroll
                for (int n = 0; n < 2; ++n) acc[a][b][m][n] = (f32x4){0.f, 0.f, 0.f, 0.f};
    bf16x8 At[4][2], B0[2][2], B1[2][2];
    const char* cA = (const char*)g.A + (size_t)cur.pm * tstep; const char* cB = (const char*)g.Bt + (size_t)cur.pn * tstep;
    PG8_STAGE(PG8_SB(0, 0), cB, voffB); PG8_STAGE(PG8_SB(0, 1), cB + hstep, voffB); PG8_STAGE(PG8_SA(0, 0), cA, voffA); PG8_STAGE(PG8_SA(0, 1), cA + hstep, voffA);
    if (wr == 1) PG8_BAR;
    PG8_WAIT_V(2); PG8_BAR;
    PG8_STAGE(PG8_SB(1, 0), cB + kstep, voffB); PG8_STAGE(PG8_SA(1, 0), cA + kstep, voffA); PG8_STAGE(PG8_SB(1, 1), cB + hstep + kstep, voffB);
    PG8_WAIT_V(6); PG8_BAR;
    for (;;) {
        const bool has_next = S.next(ui + 1, nxt);
        const char* nA = has_next ? (const char*)g.A + (size_t)nxt.pm * tstep : cA; const char* nB = has_next ? (const char*)g.Bt + (size_t)nxt.pn * tstep : cB;
        for (int t = 0; t < nt; t += 2) {
            const bool last = (t == nt - 2);
            const char* a1 = cA + (size_t)(t + 1) * kstep;
            const char* a2 = last ? nA : cA + (size_t)(t + 2) * kstep; const char* b2 = last ? nB : cB + (size_t)(t + 2) * kstep;
            const char* a3 = a2 + kstep; const char* b3 = b2 + kstep;
            PG8_LDB(B0, 0, 0); PG8_LDB(B1, 0, 1); PG8_SCHED; PG8_LDA(At, 0, 0); PG8_STAGE(PG8_SA(1, 1), a1 + hstep, voffA);
            PG8_WAIT_V(8); PG8_WAIT_L(0); PG8_BAR; PG8_MMA(0, 0, At, B0); PG8_MMA(0, 1, At, B1); PG8_BAR; PG8_SCHED;
            PG8_LDA(At, 0, 1); PG8_STAGE(PG8_SB(0, 0), b2, voffB); PG8_STAGE(PG8_SB(0, 1), b2 + hstep, voffB); PG8_STAGE(PG8_SA(0, 0), a2, voffA);
            PG8_WAIT_V(8); PG8_WAIT_L(0); PG8_BAR; PG8_MMA(1, 0, At, B0); PG8_MMA(1, 1, At, B1); PG8_BAR; PG8_SCHED;
            PG8_LDB(B0, 1, 0); PG8_LDB(B1, 1, 1); PG8_SCHED; PG8_LDA(At, 1, 0); PG8_STAGE(PG8_SA(0, 1), a2 + hstep, voffA);
            PG8_WAIT_V(8); PG8_WAIT_L(0); PG8_BAR; PG8_MMA(0, 0, At, B0); PG8_MMA(0, 1, At, B1); PG8_BAR; PG8_SCHED;
            PG8_LDA(At, 1, 1); PG8_STAGE(PG8_SB(1, 0), b3, voffB); PG8_STAGE(PG8_SB(1, 1), b3 + hstep, voffB); PG8_STAGE(PG8_SA(1, 0), a3, voffA);
            PG8_WAIT_V(8); PG8_WAIT_L(0); PG8_BAR; PG8_MMA(1, 0, At, B0); PG8_MMA(1, 1, At, B1); PG8_BAR; PG8_SCHED;
        }
        if (wr == 0) PG8_BAR;
        E(acc, cur, wr, wc, fr, fq);
        if (!has_next) break;
#pragma unroll
        for (int a = 0; a < 2; ++a)
#pragma unroll
            for (int b = 0; b < 2; ++b)
#pragma unroll
                for (int m = 0; m < 4; ++m)
#pragma unroll
                    for (int n = 0; n < 2; ++n) acc[a][b][m][n] = (f32x4){0.f, 0.f, 0.f, 0.f};
        cur = nxt; cA = nA; cB = nB; ++ui;
        if (wr == 1) PG8_BAR;
    }
    PG8_WAIT_V(0);
    PG8_BAR;
#undef PG8_SA
#undef PG8_SB
#undef PG8_STAGE
#undef PG8_LDA
#undef PG8_LDB
#undef PG8_MMA
#undef PG8_WAIT_V
#undef PG8_WAIT_L
#undef PG8_BAR
#undef PG8_SCHED
}
}

struct EpiZ {
    static constexpr bool PERM = true;
    bf16_t* O; int ldc;
    __device__ __forceinline__ void operator()(const f32x4 (&acc)[2][2][4][2], const pg8::Unit& u, int wr, int wc, int fr, int fq) const {
        const int row0 = u.pm * 256 + wr * 64 + fr, col0 = u.pn * 256 + wc * 32 + 8 * fq;
#pragma unroll
        for (int ai = 0; ai < 2; ++ai)
#pragma unroll
            for (int m = 0; m < 4; ++m) { bf16_t* rowp = O + (size_t)(row0 + ai * 128 + m * 16) * ldc + col0;
#pragma unroll
                for (int bj = 0; bj < 2; ++bj) { const f32x4 v0 = acc[ai][bj][m][0], v1 = acc[ai][bj][m][1];
                    u32x4 w; w.x = pk2(v0[0], v0[1]); w.y = pk2(v0[2], v0[3]); w.z = pk2(v1[0], v1[1]); w.w = pk2(v1[2], v1[3]);
                    *(u32x4*)(rowp + bj * 128) = w; } }
    }
};
struct EpiSwi {
    static constexpr bool PERM = true;
    bf16_t* O;
    __device__ __forceinline__ void operator()(const f32x4 (&acc)[2][2][4][2], const pg8::Unit& u, int wr, int wc, int fr, int fq) const {
        const int row0 = u.pm * 256 + wr * 64 + fr, col0 = u.pn * 128 + wc * 32 + 8 * fq;
#pragma unroll
        for (int ai = 0; ai < 2; ++ai)
#pragma unroll
            for (int m = 0; m < 4; ++m) { bf16_t* rowp = O + (size_t)(row0 + ai * 128 + m * 16) * DFF + col0;
                float h[8];
#pragma unroll
                for (int n = 0; n < 2; ++n)
#pragma unroll
                    for (int j = 0; j < 4; ++j) h[n * 4 + j] = siluf_(acc[ai][0][m][n][j]) * acc[ai][1][m][n][j];
                *(u32x4*)rowp = pack8(h); }
    }
};
struct EpiRes {
    static constexpr bool PERM = false;
    const float* xin_l; const float* xin_c; float* xout_l; float* xout_c; const float* modl; int goff;
    __device__ __forceinline__ void operator()(const f32x4 (&acc)[2][2][4][2], const pg8::Unit& u, int wr, int wc, int fr, int fq) const {
        const int b = u.pm / 9, j = u.pm - 9 * b;
        const float* xi; float* xo; const float* gv;
        if (j == 0) { const size_t off = (size_t)b * CL * D; xi = xin_c + off; xo = xout_c + off; gv = modl + 32 * 6144 + goff; }
        else { const size_t off = ((size_t)b * TL + (size_t)(j - 1) * 256) * D; xi = xin_l + off; xo = xout_l + off; gv = modl + b * 6144 + goff; }
        const int rl0 = wr * 64 + fr, col0 = u.pn * 256 + wc * 32 + 4 * fq;
        f32x4 gate[2][2];
#pragma unroll
        for (int bj = 0; bj < 2; ++bj)
#pragma unroll
            for (int n = 0; n < 2; ++n) gate[bj][n] = *(const f32x4*)(gv + col0 + bj * 128 + n * 16);
#pragma unroll
        for (int ai = 0; ai < 2; ++ai)
#pragma unroll
            for (int m = 0; m < 4; ++m) { const size_t ro = (size_t)(rl0 + ai * 128 + m * 16) * D + col0;
#pragma unroll
                for (int bj = 0; bj < 2; ++bj)
#pragma unroll
                    for (int n = 0; n < 2; ++n) { const f32x4 xv = *(const f32x4*)(xi + ro + bj * 128 + n * 16);
                        *(f32x4*)(xo + ro + bj * 128 + n * 16) = xv + gate[bj][n] * acc[ai][bj][m][n]; } }
    }
};

__device__ __forceinline__ void convert_matrix(const float* W, int K, int N, int Np, int mode, bf16_t* Bt, float* sT) {
    const int ntiles = (Np >> 6) * (K >> 6);
    const int b0_ = bid_(), gd_ = gdim_();
    const int tid = tid_(), kr = tid >> 3, c8 = (tid & 7) * 8;
    const int nK = K >> 6;
    for (int t0 = b0_; t0 < ntiles; t0 += 4 * gd_) {
        float4 v0[4], v1[4]; int n0a[4], k0a[4];
#pragma unroll
        for (int u = 0; u < 4; ++u) { const int tile = t0 + u * gd_; v0[u] = (float4){0.f, 0.f, 0.f, 0.f}; v1[u] = v0[u]; n0a[u] = 0; k0a[u] = 0;
            if (tile < ntiles) { const int nt = tile / nK, kt = tile - nt * nK; const int n0 = nt * 64, k0 = kt * 64; n0a[u] = n0; k0a[u] = k0;
                int src0 = n0;
                if (mode == 1) { const int pn = n0 >> 8, rem = n0 & 255, half = rem >> 7, jj = rem & 127; src0 = half * DFF + pn * 128 + jj; }
                const float* src = W + (size_t)(k0 + kr) * N + src0 + c8;
                if (src0 + c8 < N) { v0[u] = *(const float4*)src; v1[u] = *(const float4*)(src + 4); } } }
#pragma unroll
        for (int u = 0; u < 4; ++u) { const int tile = t0 + u * gd_;
            if (tile < ntiles) {
                float* d = sT + kr * 65 + c8;
                d[0] = v0[u].x; d[1] = v0[u].y; d[2] = v0[u].z; d[3] = v0[u].w; d[4] = v1[u].x; d[5] = v1[u].y; d[6] = v1[u].z; d[7] = v1[u].w;
                __syncthreads();
                const int nr = tid >> 3, kg = (tid & 7) * 8;
                float o[8];
#pragma unroll
                for (int jj = 0; jj < 8; ++jj) o[jj] = sT[(kg + jj) * 65 + nr];
                *(u32x4*)(Bt + (size_t)(n0a[u] + nr) * K + k0a[u] + kg) = pack8(o);
                __syncthreads(); } }
    }
}
__device__ __forceinline__ void mod_item(const Params& p, int item, float* sS, float* sRed) {
    const int l = item / 48, cb = item - l * 48; const int tid = tid_(), c = tid & 127, kq = tid >> 7;
    const float* wm = inp(4) + (size_t)l * 1024 * 6144 + cb * 128 + c; const float* cvec = inp(1); const float* cctx = inp(3); const float* bmod = inp(5);
    float acc[33];
#pragma unroll
    for (int r = 0; r < 33; ++r) acc[r] = 0.f;
    for (int kc = 0; kc < 4; ++kc) {
        __syncthreads();
        for (int idx = tid; idx < 33 * 256; idx += 512) { const int r = idx >> 8, k = kc * 256 + (idx & 255);
            const float cv = (r < 32) ? cvec[r * 1024 + k] : cctx[k]; sS[idx] = siluf_(cv); }
        __syncthreads();
        for (int kk = 0; kk < 64; kk += 8) { const int kl = kq * 64 + kk; float w[8];
#pragma unroll
            for (int u = 0; u < 8; ++u) w[u] = wm[(size_t)(kc * 256 + kl + u) * 6144];
#pragma unroll
            for (int u = 0; u < 8; ++u)
#pragma unroll
                for (int r = 0; r < 33; ++r) acc[r] += sS[r * 256 + kl + u] * w[u]; }
    }
#pragma unroll
    for (int r = 0; r < 33; ++r) sRed[(kq * 33 + r) * 128 + c] = acc[r];
    __syncthreads();
    float* mod = (float*)(wsp() + OFF_MOD);
    for (int idx = tid; idx < 33 * 128; idx += 512) { const int r = idx >> 7, cc = idx & 127;
        float v = bmod[l * 6144 + cb * 128 + cc];
#pragma unroll
        for (int q = 0; q < 4; ++q) v += sRed[(q * 33 + r) * 128 + cc];
        mod[(size_t)(l * 33 + r) * 6144 + cb * 128 + cc] = v; }
    __syncthreads();
}

__device__ __forceinline__ void norm_phase(const float* xl, const float* xc, const float* g, const float* modl, int sh_off, int sc_off, bf16_t* H) {
    const int tid = tid_(), lane = tid & 63, gw = bid_() * 8 + (tid >> 6), nw = gdim_() * 8; const int a32 = x32addr_();
    for (int r4 = gw; r4 < MROWS / 4; r4 += nw) {
        const int row = r4 * 4; const int b = row / TT, t = row - b * TT;
        const float* src = (t < CL) ? xc + ((size_t)b * CL + t) * D : xl + ((size_t)b * TL + (t - CL)) * D;
        const float* mv = modl + (size_t)((t < CL) ? 32 : b) * 6144;
        f32x4 v[4][4];
#pragma unroll
        for (int rr = 0; rr < 4; ++rr)
#pragma unroll
            for (int i = 0; i < 4; ++i) v[rr][i] = *(const f32x4*)(src + (size_t)rr * D + i * 256 + lane * 4);
        f32x4 mul[4], sh[4];
#pragma unroll
        for (int i = 0; i < 4; ++i) { const int c = i * 256 + lane * 4; mul[i] = *(const f32x4*)(g + c) * (*(const f32x4*)(mv + sc_off + c) + 1.0f); sh[i] = *(const f32x4*)(mv + sh_off + c); }
#pragma unroll
        for (int rr = 0; rr < 4; ++rr) {
            float ss = 0.f;
#pragma unroll
            for (int i = 0; i < 4; ++i) ss += v[rr][i][0] * v[rr][i][0] + v[rr][i][1] * v[rr][i][1] + v[rr][i][2] * v[rr][i][2] + v[rr][i][3] * v[rr][i][3];
            ss = red64(ss, a32);
            const float rs = rsqrtf(ss * (1.0f / 1024.0f) + 1e-6f);
#pragma unroll
            for (int i = 0; i < 4; ++i) { const f32x4 y = v[rr][i] * rs * mul[i] + sh[i];
                u32x2 w; w.x = pk2(y[0], y[1]); w.y = pk2(y[2], y[3]);
                *(u32x2*)(H + (size_t)(row + rr) * D + i * 256 + lane * 4) = w; }
        }
    }
}

__device__ __forceinline__ float shift3(float z, float pv, float nx, float m0, float m1) { return z + m0 * (pv - z) + m1 * (nx - z); }
__device__ __forceinline__ void even_feat_phase(const Params& p, int j, const bf16_t* Z, bf16_t* F, float* sm) {
    constexpr int WS = 104;
    const int tid = tid_(), lane = tid & 63, w = __builtin_amdgcn_readfirstlane(tid >> 6), q = lane & 15, g = lane >> 4;
    bf16_t* sLR = (bf16_t*)sm;
    bf16_t* sWT = sLR + 2 * 16 * WS;
    const float* mu = inp(15) + (size_t)j * 2 * 1728;
    const int b0_ = bid_(), gd_ = gdim_();
    int lj[3], ltk[3];
#pragma unroll
    for (int u = 0; u < 3; ++u) { const int idx = tid + 512 * u; lj[u] = idx >> 4; ltk[u] = idx & 15; }
    const int cb = 64 * w + 2 * q;
    {
        const float* wup = inp(17) + (size_t)j * 2 * 32 * 512;
        const float* aup = inp(19) + (size_t)j * 32 * 512;
        __syncthreads();
#pragma unroll 8
        for (int k = 0; k < 32; ++k) { sWT[tid * WS + k] = (bf16_t)f2bf(wup[k * 512 + tid]); sWT[tid * WS + 32 + k] = (bf16_t)f2bf(wup[(32 + k) * 512 + tid]); sWT[tid * WS + 64 + k] = (bf16_t)f2bf(aup[k * 512 + tid]); }
        __syncthreads();
        float w0f[4], w0b[4], a0c[4], kkc[4], kac[4], mr0[4], mr1[4], mk0[4], mk1[4], mv0[4], mv1[4];
#pragma unroll
        for (int ct = 0; ct < 4; ++ct) { const int c = cb + 32 * (ct >> 1) + (ct & 1);
            w0f[ct] = inp(16)[(size_t)j * 1024 + c]; w0b[ct] = inp(16)[(size_t)j * 1024 + 512 + c]; a0c[ct] = inp(18)[(size_t)j * 512 + c]; kkc[ct] = inp(21)[j * 512 + c]; kac[ct] = inp(22)[j * 512 + c];
            mr0[ct] = mu[c]; mr1[ct] = mu[1728 + c]; mk0[ct] = mu[512 + c]; mk1[ct] = mu[1728 + 512 + c]; mv0[ct] = mu[1024 + c]; mv1[ct] = mu[1728 + 1024 + c]; }
        float ml0[3], ml1[3];
#pragma unroll
        for (int u = 0; u < 3; ++u) { ml0[u] = mu[1536 + lj[u]]; ml1[u] = mu[1728 + 1536 + lj[u]]; }
        for (int chunk = b0_; chunk < 256; chunk += gd_) {
            const int r0 = chunk * 144, t0 = (chunk & 15) * 144;
            bf16_t lw[3][3];
            auto load_group = [&](int gi) {
#pragma unroll
                for (int u = 0; u < 3; ++u) { const bf16_t* zl = Z + ((size_t)(r0 + 16 * gi + ltk[u]) * EV_INP + 1568 + 1536 + lj[u]) - EV_INP;
                    lw[u][0] = zl[0]; lw[u][1] = zl[EV_INP]; lw[u][2] = zl[2 * EV_INP]; }
            };
            load_group(0);
#pragma unroll 1
            for (int gi = 0; gi < 9; ++gi) {
                bf16_t* lr = sLR + (gi & 1) * 16 * WS;
#pragma unroll
                for (int u = 0; u < 3; ++u) { const int t = t0 + 16 * gi + ltk[u];
                    const bool hp = (t != 0) && (t != CL), hn = (t != CL - 1) && (t != TT - 1);
                    const float sl = shift3(bf1(lw[u][1]), hp ? bf1(lw[u][0]) : 0.f, hn ? bf1(lw[u][2]) : 0.f, ml0[u], ml1[u]);
                    lr[ltk[u] * WS + lj[u]] = (bf16_t)f2bf((lj[u] < 64) ? (2.0f * sigmoidf_(2.0f * sl) - 1.0f) : sl); }
                unsigned zr_[2][6], zk_[2][6], zv_[2][6];
                { const bf16_t* zb = Z + ((size_t)(r0 + 16 * gi + 4 * g) * EV_INP + 1568 + cb) - EV_INP;
#pragma unroll
                  for (int i = 0; i < 6; ++i)
#pragma unroll
                      for (int pp = 0; pp < 2; ++pp) { const bf16_t* zz = zb + (size_t)i * EV_INP + 32 * pp; zr_[pp][i] = *(const unsigned*)zz; zk_[pp][i] = *(const unsigned*)(zz + 512); zv_[pp][i] = *(const unsigned*)(zz + 1024); } }
                if (gi + 1 < 9) load_group(gi + 1);
                __syncthreads();
                f32x4 Cf[4], Cb[4], Ca[4];
                { const bf16x8 A0 = *(const bf16x8*)(lr + q * WS + 8 * g), A1 = *(const bf16x8*)(lr + q * WS + 32 + 8 * g), A2 = *(const bf16x8*)(lr + q * WS + 64 + 8 * g);
                  const f32x4 z4 = {0.f, 0.f, 0.f, 0.f};
                  const LAS bf16_t* wq = (const LAS bf16_t*)sWT + (64 * w + 2 * q) * WS + 8 * g; asm volatile("" : "+v"(wq));
#pragma unroll
                  for (int ct = 0; ct < 4; ++ct) { const LAS bf16_t* wc = wq + (32 * (ct >> 1) + (ct & 1)) * WS;
                      Cf[ct] = __builtin_amdgcn_mfma_f32_16x16x32_bf16(A0, *(const LAS bf16x8*)(wc), z4, 0, 0, 0); Cb[ct] = __builtin_amdgcn_mfma_f32_16x16x32_bf16(A1, *(const LAS bf16x8*)(wc + 32), z4, 0, 0, 0);
                      Ca[ct] = __builtin_amdgcn_mfma_f32_16x16x32_bf16(A2, *(const LAS bf16x8*)(wc + 64), z4, 0, 0, 0); } }
#pragma unroll
                for (int r = 0; r < 4; ++r) { const int t = t0 + 16 * gi + 4 * g + r;
                    const bool hp = (t != 0) && (t != CL), hn = (t != CL - 1) && (t != TT - 1);
                    float rs[4], ks[4], vs[4], kk[4], a[4], ss = 0.f;
#pragma unroll
                    for (int ct = 0; ct < 4; ++ct) {
#define FH(zz, i) ((ct & 1) ? bfhi(zz[ct >> 1][i]) : bflo(zz[ct >> 1][i]))
                        rs[ct] = shift3(FH(zr_, r + 1), hp ? FH(zr_, r) : 0.f, hn ? FH(zr_, r + 2) : 0.f, mr0[ct], mr1[ct]);
                        ks[ct] = shift3(FH(zk_, r + 1), hp ? FH(zk_, r) : 0.f, hn ? FH(zk_, r + 2) : 0.f, mk0[ct], mk1[ct]);
                        vs[ct] = shift3(FH(zv_, r + 1), hp ? FH(zv_, r) : 0.f, hn ? FH(zv_, r + 2) : 0.f, mv0[ct], mv1[ct]);
#undef FH
                        kk[ct] = ks[ct] * kkc[ct]; ss += kk[ct] * kk[ct]; a[ct] = sigmoidf_(Ca[ct][r] + a0c[ct]); }
                    const float rn = __builtin_amdgcn_rsqf(fmaxf(red16(ss), 1e-24f));
                    bf16_t* fo = F + (size_t)(r0 + 16 * gi + 4 * g + r) * 4096 + cb;
                    float o_k[4], o_a[4], o_b[4], o_f[4], o_e[4];
#pragma unroll
                    for (int ct = 0; ct < 4; ++ct) { const float kkn = kk[ct] * rn;
                        o_k[ct] = ks[ct] * (1.0f + (a[ct] - 1.0f) * kac[ct]); o_a[ct] = -kkn; o_b[ct] = kkn * a[ct];
                        o_f[ct] = 0.6065306597126334f * sigmoidf_(Cf[ct][r] + w0f[ct]);
                        o_e[ct] = 0.6065306597126334f * sigmoidf_(Cb[ct][r] + w0b[ct]); }
#pragma unroll
                    for (int pp = 0; pp < 2; ++pp) { bf16_t* f1 = fo + 32 * pp;
                        *(unsigned*)(f1) = pk2(rs[2 * pp], rs[2 * pp + 1]); *(unsigned*)(f1 + 512) = pk2(o_k[2 * pp], o_k[2 * pp + 1]); *(unsigned*)(f1 + 1024) = pk2(vs[2 * pp], vs[2 * pp + 1]);
                        *(unsigned*)(f1 + 1536) = pk2(o_a[2 * pp], o_a[2 * pp + 1]); *(unsigned*)(f1 + 2048) = pk2(o_b[2 * pp], o_b[2 * pp + 1]);
                        *(unsigned*)(f1 + 2560) = pk2(o_f[2 * pp], o_f[2 * pp + 1]); *(unsigned*)(f1 + 3072) = pk2(o_e[2 * pp], o_e[2 * pp + 1]); }
                }
            }
            __syncthreads();
        }
    }
    {
        const float* gup = inp(20) + (size_t)j * 96 * 512;
        __syncthreads();
#pragma unroll 8
        for (int k = 0; k < 96; ++k) sWT[tid * WS + k] = (bf16_t)f2bf(gup[k * 512 + tid]);
        __syncthreads();
        float ml0[3], ml1[3];
#pragma unroll
        for (int u = 0; u < 3; ++u) { ml0[u] = mu[1632 + lj[u]]; ml1[u] = mu[1728 + 1632 + lj[u]]; }
        for (int chunk = b0_; chunk < 256; chunk += gd_) {
            const int r0 = chunk * 144, t0 = (chunk & 15) * 144;
            bf16_t lw[3][3];
            auto load_group = [&](int gi) {
#pragma unroll
                for (int u = 0; u < 3; ++u) { const bf16_t* zl = Z + ((size_t)(r0 + 16 * gi + ltk[u]) * EV_INP + 1568 + 1632 + lj[u]) - EV_INP;
                    lw[u][0] = zl[0]; lw[u][1] = zl[EV_INP]; lw[u][2] = zl[2 * EV_INP]; }
            };
            load_group(0);
#pragma unroll 1
            for (int gi = 0; gi < 9; ++gi) {
                bf16_t* lr = sLR + (gi & 1) * 16 * WS;
#pragma unroll
                for (int u = 0; u < 3; ++u) { const int t = t0 + 16 * gi + ltk[u];
                    const bool hp = (t != 0) && (t != CL), hn = (t != CL - 1) && (t != TT - 1);
                    lr[ltk[u] * WS + lj[u]] = (bf16_t)f2bf(sigmoidf_(shift3(bf1(lw[u][1]), hp ? bf1(lw[u][0]) : 0.f, hn ? bf1(lw[u][2]) : 0.f, ml0[u], ml1[u]))); }
                if (gi + 1 < 9) load_group(gi + 1);
                __syncthreads();
                const bf16x8 A0 = *(const bf16x8*)(lr + q * WS + 8 * g), A1 = *(const bf16x8*)(lr + q * WS + 32 + 8 * g), A2 = *(const bf16x8*)(lr + q * WS + 64 + 8 * g);
                const LAS bf16_t* wq = (const LAS bf16_t*)sWT + (64 * w + 2 * q) * WS + 8 * g; asm volatile("" : "+v"(wq));
                f32x4 cg_[4];
#pragma unroll
                for (int ct = 0; ct < 4; ++ct) { f32x4 c4 = {0.f, 0.f, 0.f, 0.f}; const LAS bf16_t* wc = wq + (32 * (ct >> 1) + (ct & 1)) * WS;
                    c4 = __builtin_amdgcn_mfma_f32_16x16x32_bf16(A0, *(const LAS bf16x8*)(wc), c4, 0, 0, 0); c4 = __builtin_amdgcn_mfma_f32_16x16x32_bf16(A1, *(const LAS bf16x8*)(wc + 32), c4, 0, 0, 0); c4 = __builtin_amdgcn_mfma_f32_16x16x32_bf16(A2, *(const LAS bf16x8*)(wc + 64), c4, 0, 0, 0);
                    cg_[ct] = c4; }
#pragma unroll
                for (int r = 0; r < 4; ++r)
#pragma unroll
                    for (int pp = 0; pp < 2; ++pp) *(unsigned*)(F + (size_t)(r0 + 16 * gi + 4 * g + r) * 4096 + 3584 + cb + 32 * pp) = pk2(cg_[2 * pp][r], cg_[2 * pp + 1][r]);
            }
            __syncthreads();
        }
    }
}

__device__ __forceinline__ int scan_tok(int s, int dir) { return dir == 0 ? s : (s < CL ? (CL - 1 - s) : (TT + CL - 1 - s)); }
__device__ __forceinline__ void rwkv_scan_phase(const bf16_t* F, bf16_t* O, float* sm) {
    const int tid = tid_(), rp = (tid >> 3) & 31, kg = tid & 7; const int b0_ = bid_(), gd_ = gdim_();
    float* sF = sm;
    float* sO = sm + 2 * 6 * 32 * 64;
    for (int item = b0_; item < 256; item += gd_) {
        const int bl = item >> 4, h = (item >> 1) & 7, dir = item & 1;
        const size_t rb = (size_t)bl * TT;
        f32x4 S[4] = {{0.f, 0.f, 0.f, 0.f}, {0.f, 0.f, 0.f, 0.f}, {0.f, 0.f, 0.f, 0.f}, {0.f, 0.f, 0.f, 0.f}};
        u32x4 pre[3];
        auto load_tile = [&](int tile) {
#pragma unroll
            for (int i = 0; i < 3; ++i) { const int q = tid + 512 * i, pair = q >> 3, part = q & 7, tokl = pair / 6, feat = pair - tokl * 6;
                const int tk = scan_tok(tile * 32 + tokl, dir);
                const int fo = (feat < 5) ? feat * 512 : (2560 + 512 * dir);
                pre[i] = *(const u32x4*)(F + (rb + tk) * 4096 + fo + h * 64 + part * 8); }
        };
        auto store_tile = [&](int buf) {
#pragma unroll
            for (int i = 0; i < 3; ++i) { const int q = tid + 512 * i, pair = q >> 3, part = q & 7, tokl = pair / 6, feat = pair - tokl * 6;
                float v[8]; unpack8(pre[i], v);
                if (feat == 5) {
#pragma unroll
                    for (int jx = 0; jx < 8; ++jx) v[jx] = __expf(-v[jx]); }
                float* d = sF + (((buf * 6 + feat) * 32 + tokl) * 64 + part * 8);
                *(f32x4*)d = (f32x4){v[0], v[1], v[2], v[3]}; *(f32x4*)(d + 4) = (f32x4){v[4], v[5], v[6], v[7]}; }
        };
        __syncthreads();
        load_tile(0); store_tile(0);
        __syncthreads();
        for (int tile = 0; tile < 72; ++tile) {
            const int buf = tile & 1;
            if (tile + 1 < 72) load_tile(tile + 1);
            const float* fb = sF + buf * 6 * 32 * 64;
            float* ob = sO + buf * 32 * 64;
#define RW_LOAD(P, off) { const float* fr_ = pa_ + (off); _Pragma("unroll") for (int e = 0; e < 2; ++e) { P##r[e] = *(const f32x4*)(fr_ + 4 * e); P##k[e] = *(const f32x4*)(fr_ + 2048 + 4 * e); \
                P##a[e] = *(const f32x4*)(fr_ + 3 * 2048 + 4 * e); P##b[e] = *(const f32x4*)(fr_ + 4 * 2048 + 4 * e); P##w[e] = *(const f32x4*)(fr_ + 5 * 2048 + 4 * e); } \
                P##v0 = pv_[(off)]; P##v1 = pv_[(off) + 1]; }
#define RW_STEP(P, off) { f32x4 ac0 = S[0] * P##a[0]; ac0 += S[1] * P##a[1]; f32x4 ac1 = S[2] * P##a[0]; ac1 += S[3] * P##a[1]; \
                const f32x2 pa0_ = __builtin_shufflevector(ac0, ac0, 0, 1) + __builtin_shufflevector(ac0, ac0, 2, 3), pa1_ = __builtin_shufflevector(ac1, ac1, 0, 1) + __builtin_shufflevector(ac1, ac1, 2, 3); \
                float sa0 = pa0_[0] + pa0_[1], sa1 = pa1_[0] + pa1_[1]; sa0 = red8(sa0); sa1 = red8(sa1); \
                S[0] = S[0] * P##w[0] + (sa0 * P##b[0] + P##v0 * P##k[0]); S[1] = S[1] * P##w[1] + (sa0 * P##b[1] + P##v0 * P##k[1]); \
                S[2] = S[2] * P##w[0] + (sa1 * P##b[0] + P##v1 * P##k[0]); S[3] = S[3] * P##w[1] + (sa1 * P##b[1] + P##v1 * P##k[1]); \
                f32x4 oc0 = S[0] * P##r[0]; oc0 += S[1] * P##r[1]; f32x4 oc1 = S[2] * P##r[0]; oc1 += S[3] * P##r[1]; \
                const f32x2 po0_ = __builtin_shufflevector(oc0, oc0, 0, 1) + __builtin_shufflevector(oc0, oc0, 2, 3), po1_ = __builtin_shufflevector(oc1, oc1, 0, 1) + __builtin_shufflevector(oc1, oc1, 2, 3); \
                float o0 = po0_[0] + po0_[1], o1 = po1_[0] + po1_[1]; { const float x0_ = o0 + dppf<0x141>(o0), x1_ = o1 + dppf<0x141>(o1); float x_ = hi4 ? x1_ : x0_; x_ += dppf<0xB1>(x_); x_ += dppf<0x4E>(x_); po_[(off)] = x_; } }
            const bool hi4 = (kg & 4) != 0;
            if (tid < 256) { f32x4 Ar[2], Ak[2], Aa[2], Ab[2], Aw[2], Br[2], Bk[2], Ba[2], Bb[2], Bw[2]; float Av0, Av1, Bv0, Bv1;
              const float* pa_ = fb + kg * 8; const float* pv_ = fb + 2 * 2048 + 2 * rp; float* po_ = ob + 2 * rp + (kg >> 2);
              RW_LOAD(A, 0)
#pragma unroll 1
              for (int i = 0; i < 32; i += 2) {
                  RW_LOAD(B, 64)
                  RW_STEP(A, 0)
                  RW_LOAD(A, 128)
                  RW_STEP(B, 64)
                  pa_ += 128; pv_ += 128; po_ += 128;
              } }
#undef RW_LOAD
#undef RW_STEP
            if (tile + 1 < 72) store_tile(buf ^ 1);
            __syncthreads();
            { const int tokl = tid >> 4, c4 = (tid & 15) * 4; const int tk = scan_tok(tile * 32 + tokl, dir);
              const f32x4 v = *(const f32x4*)(ob + tokl * 64 + c4);
              u32x2 w; w.x = pk2(v[0], v[1]); w.y = pk2(v[2], v[3]);
              *(u32x2*)(O + (rb + tk) * 2048 + 1024 + 512 * dir + h * 64 + c4) = w; }
        }
        __syncthreads();
    }
}

__device__ __forceinline__ void gla_phase(const Params& p, int j, const bf16_t* Z, bf16_t* O, float* sm) {
    constexpr int LS = 68, BS = 72;
    bf16_t* sQb = (bf16_t*)sm; bf16_t* sKb = sQb + 64 * BS; bf16_t* sKdT = sKb + 64 * BS; bf16_t* sVT = sKdT + 64 * BS; bf16_t* sAtt = sVT + 64 * BS; bf16_t* sST = sAtt + 64 * BS;
    float* sB = (float*)(sST + 64 * BS);
    float* sAup = sB + 64 * LS; float* sAd = sAup + 16 * 64; float* sSeg = sAd + 64 * 16; float* sTot = sSeg + 8 * 64;
    const int tid = tid_(), lane = tid & 63, wid = tid >> 6, q = lane & 15, g = lane >> 4; const int b0_ = bid_(), gd_ = gdim_();
    const int ti = wid >> 1, tc0 = (wid & 1) * 2;
    const int tok = tid >> 3, d0 = (tid & 7) * 8;
    for (int item = b0_; item < 256; item += gd_) {
        const int bl = item >> 4, h = (item >> 2) & 3, dir = (item >> 1) & 1, vh = item & 1;
        const size_t rb = (size_t)bl * TT;
        const float* aup = inp(12) + ((size_t)(j * 2 + dir) * 16) * 256 + h * 64;
        const float* abias = inp(13) + (size_t)(j * 2 + dir) * 256 + h * 64;
        __syncthreads();
        for (int idx = tid; idx < 64 * BS; idx += 512) sST[idx] = 0;
        float aupc[16]; const float biasc = abias[tid & 63];
#pragma unroll
        for (int i = 0; i < 16; ++i) aupc[i] = aup[i * 256 + (tid & 63)];
        f32x4 STa[2] = {{0.f, 0.f, 0.f, 0.f}, {0.f, 0.f, 0.f, 0.f}};
        u32x4 rq, rk, rv, ra;
        auto load_raw = [&](int ci) {
            const bf16_t* zr = Z + (rb + scan_tok(ci * 64 + tok, dir)) * EV_INP;
            rq = *(const u32x4*)(zr + h * 64 + d0); rk = *(const u32x4*)(zr + 256 + h * 64 + d0); rv = *(const u32x4*)(zr + 512 + h * 128 + vh * 64 + d0);
            const int t2 = (tid < 128) ? (tid >> 1) : 0;
            ra = *(const u32x4*)(Z + (rb + scan_tok(ci * 64 + t2, dir)) * EV_INP + 1536 + dir * 16 + (tid & 1) * 8);
        };
        load_raw(0);
        __syncthreads();
        for (int ci = 0; ci < 36; ++ci) {
            float q8[8], k8[8], v8[8];
            unpack8(rq, q8); unpack8(rk, k8); unpack8(rv, v8);
            if (tid < 128) { float a8[8]; unpack8(ra, a8);
                *(f32x4*)(sAd + (tid >> 1) * 16 + (tid & 1) * 8) = (f32x4){a8[0], a8[1], a8[2], a8[3]}; *(f32x4*)(sAd + (tid >> 1) * 16 + (tid & 1) * 8 + 4) = (f32x4){a8[4], a8[5], a8[6], a8[7]}; }
            __syncthreads();
            float loc[8];
            { const int dd = tid & 63, seg = tid >> 6; float run = 0.f;
#pragma unroll
              for (int i = 0; i < 8; ++i) { const float* ar = sAd + (seg * 8 + i) * 16;
                  const f32x4 a0 = *(const f32x4*)ar, a1 = *(const f32x4*)(ar + 4), a2 = *(const f32x4*)(ar + 8), a3 = *(const f32x4*)(ar + 12);
                  float x = biasc;
#pragma unroll
                  for (int e = 0; e < 4; ++e) { x += a0[e] * aupc[e]; x += a1[e] * aupc[4 + e]; x += a2[e] * aupc[8 + e]; x += a3[e] * aupc[12 + e]; }
                  run += (fminf(x, 0.f) - __logf(1.0f + __expf(-fabsf(x)))) * (1.0f / 16.0f); loc[i] = run; }
              sSeg[seg * 64 + dd] = run; }
            __syncthreads();
            { const int dd = tid & 63, seg = tid >> 6; float pre = 0.f;
              for (int s2 = 0; s2 < seg; ++s2) pre += sSeg[s2 * 64 + dd];
#pragma unroll
              for (int i = 0; i < 8; ++i) sB[(seg * 8 + i) * LS + dd] = loc[i] + pre; }
            __syncthreads();
            { float qb[8], kb[8];
#pragma unroll
              for (int i = 0; i < 8; ++i) { const float bb = sB[tok * LS + d0 + i], tot = sB[63 * LS + d0 + i];
                  qb[i] = q8[i] * 0.125f * __expf(bb); kb[i] = k8[i] * __expf(-bb);
                  sKdT[(d0 + i) * BS + tok] = (bf16_t)f2bf(k8[i] * __expf(tot - bb));
                  sVT[(d0 + i) * BS + tok] = (bf16_t)f2bf(v8[i]);
                  if (tok == 63) sTot[d0 + i] = tot; }
              *(u32x4*)(sQb + tok * BS + d0) = pack8(qb); *(u32x4*)(sKb + tok * BS + d0) = pack8(kb); }
            if (ci + 1 < 36) load_raw(ci + 1);
            __syncthreads();
            f32x4 oacc[2];
            { bf16x8 Aq[2];
#pragma unroll
              for (int ks = 0; ks < 2; ++ks) Aq[ks] = *(const bf16x8*)(sQb + (16 * ti + q) * BS + 32 * ks + 8 * g);
#pragma unroll
              for (int c = 0; c < 2; ++c) { const int tj = tc0 + c;
                  f32x4 at = {0.f, 0.f, 0.f, 0.f};
                  if (tj <= ti) {
#pragma unroll
                      for (int ks = 0; ks < 2; ++ks) { const bf16x8 Bk = *(const bf16x8*)(sKb + (16 * tj + q) * BS + 32 * ks + 8 * g); at = __builtin_amdgcn_mfma_f32_16x16x32_bf16(Aq[ks], Bk, at, 0, 0, 0); }
                      if (tj == ti) {
#pragma unroll
                          for (int r = 0; r < 4; ++r) if (q > 4 * g + r) at[r] = 0.f; } }
#pragma unroll
                  for (int r = 0; r < 4; ++r) sAtt[(16 * ti + 4 * g + r) * BS + 16 * tj + q] = (bf16_t)f2bf(at[r]);
                  f32x4 oc = {0.f, 0.f, 0.f, 0.f};
#pragma unroll
                  for (int ks = 0; ks < 2; ++ks) { const bf16x8 Bs = *(const bf16x8*)(sST + (16 * tj + q) * BS + 32 * ks + 8 * g); oc = __builtin_amdgcn_mfma_f32_16x16x32_bf16(Aq[ks], Bs, oc, 0, 0, 0); }
                  oacc[c] = oc; } }
            __syncthreads();
            { bf16x8 Aa[2], Av[2];
#pragma unroll
              for (int ks = 0; ks < 2; ++ks) { Aa[ks] = *(const bf16x8*)(sAtt + (16 * ti + q) * BS + 32 * ks + 8 * g); Av[ks] = *(const bf16x8*)(sVT + (16 * ti + q) * BS + 32 * ks + 8 * g); }
#pragma unroll
              for (int c = 0; c < 2; ++c) { const int tv = tc0 + c;
                  f32x4 oc = oacc[c];
#pragma unroll
                  for (int ks = 0; ks < 2; ++ks) { const bf16x8 Bv = *(const bf16x8*)(sVT + (16 * tv + q) * BS + 32 * ks + 8 * g); oc = __builtin_amdgcn_mfma_f32_16x16x32_bf16(Aa[ks], Bv, oc, 0, 0, 0); }
#pragma unroll
                  for (int r = 0; r < 4; ++r) { const int tk = scan_tok(ci * 64 + 16 * ti + 4 * g + r, dir);
                      O[(rb + tk) * 2048 + 512 * dir + h * 128 + vh * 64 + 16 * tv + q] = (bf16_t)f2bf(oc[r]); }
                  const float et = __expf(sTot[16 * tv + q]);
                  f32x4 st = STa[c] * et;
#pragma unroll
                  for (int ks = 0; ks < 2; ++ks) { const bf16x8 Bkd = *(const bf16x8*)(sKdT + (16 * tv + q) * BS + 32 * ks + 8 * g); st = __builtin_amdgcn_mfma_f32_16x16x32_bf16(Av[ks], Bkd, st, 0, 0, 0); }
                  STa[c] = st;
#pragma unroll
                  for (int r = 0; r < 4; ++r) sST[(16 * ti + 4 * g + r) * BS + 16 * tv + q] = (bf16_t)f2bf(st[r]); } }
            __syncthreads();
        }
    }
}

__device__ __forceinline__ void even_merge_phase(const Params& p, int j, const bf16_t* Z, const bf16_t* F, const bf16_t* O, bf16_t* Y) {
    const int tid = tid_(), lane = tid & 63, gw = bid_() * 8 + (tid >> 6), nw = gdim_() * 8;
    const int c8 = lane * 8;
    const float* pgg = inp(14); const float* plg = inp(24); const float* plb = inp(25); const float* prk = inp(23);
    float gg[8], lg[8], lb[8], rk[8];
#pragma unroll
    for (int i = 0; i < 8; ++i) { gg[i] = pgg[j * 128 + ((c8 + i) & 127)]; lg[i] = plg[j * 512 + c8 + i]; lb[i] = plb[j * 512 + c8 + i]; rk[i] = prk[j * 512 + c8 + i]; }
    for (int zl0 = gw * 2; zl0 < HROWS; zl0 += nw * 2) {
        u32x4 L[2][9];
#pragma unroll
        for (int tt = 0; tt < 2; ++tt) { const int zl = zl0 + tt;
            const bf16_t* orow = O + (size_t)zl * 2048; const bf16_t* zrow = Z + (size_t)zl * EV_INP; const bf16_t* frow = F + (size_t)zl * 4096;
            L[tt][0] = *(const u32x4*)(orow + c8); L[tt][1] = *(const u32x4*)(orow + 512 + c8); L[tt][2] = *(const u32x4*)(zrow + 1024 + c8);
            L[tt][3] = *(const u32x4*)(orow + 1024 + c8); L[tt][4] = *(const u32x4*)(orow + 1536 + c8);
            L[tt][5] = *(const u32x4*)(frow + c8); L[tt][6] = *(const u32x4*)(frow + 512 + c8); L[tt][7] = *(const u32x4*)(frow + 1024 + c8); L[tt][8] = *(const u32x4*)(frow + 3584 + c8); }
#pragma unroll
        for (int tt = 0; tt < 2; ++tt) { const int zl = zl0 + tt;
            float a[8], b[8], y[8];
            unpack8(L[tt][0], a); unpack8(L[tt][1], b);
            float ss = 0.f;
#pragma unroll
            for (int i = 0; i < 8; ++i) { a[i] += b[i]; ss += a[i] * a[i]; }
            ss = red16(ss);
            const float rs = rsqrtf(ss * (1.0f / 128.0f) + 1e-6f);
            unpack8(L[tt][2], b);
#pragma unroll
            for (int i = 0; i < 8; ++i) y[i] = a[i] * rs * gg[i] * siluf_(b[i]);
            *(u32x4*)(Y + (size_t)zl * D + c8) = pack8(y);
            unpack8(L[tt][3], a); unpack8(L[tt][4], b);
            float sm_ = 0.f;
#pragma unroll
            for (int i = 0; i < 8; ++i) { a[i] += b[i]; sm_ += a[i]; }
            const float mean = red8(sm_) * (1.0f / 64.0f);
            float sv = 0.f;
#pragma unroll
            for (int i = 0; i < 8; ++i) { a[i] -= mean; sv += a[i] * a[i]; }
            const float rstd = rsqrtf(red8(sv) * (1.0f / 64.0f) + 64e-5f);
            float r8[8], k8[8], v8[8], g8[8];
            unpack8(L[tt][5], r8); unpack8(L[tt][6], k8); unpack8(L[tt][7], v8); unpack8(L[tt][8], g8);
            float bs = 0.f;
#pragma unroll
            for (int i = 0; i < 8; ++i) bs += r8[i] * k8[i] * rk[i];
            bs = red8(bs);
#pragma unroll
            for (int i = 0; i < 8; ++i) y[i] = (a[i] * rstd * lg[i] + lb[i] + bs * v8[i]) * g8[i];
            *(u32x4*)(Y + (size_t)zl * D + 512 + c8) = pack8(y);
        }
    }
}

__device__ __forceinline__ void odd_feat_phase(const Params& p, int j, bf16_t* Z, bf16_t* VTG, bf16_t* VTN, float* sm) {
    const int tid = tid_(), lane = tid & 63, wid = tid >> 6; const int b0_ = bid_(), gd_ = gdim_();
    bf16_t* sVT = (bf16_t*)sm;
    const int c8 = lane * 8, d0 = (lane & 7) * 8;
    const float* pqg = inp(28); const float* pkg = inp(29);
    float qg[8], kg_[8], inv[8];
#pragma unroll
    for (int i = 0; i < 8; ++i) { qg[i] = pqg[j * 64 + d0 + i]; kg_[i] = pkg[j * 64 + d0 + i]; inv[i] = exp2f(-(float)((d0 & 15) + i) * (13.287712379549449f / 16.0f)); }
    const int ax = d0 >> 5, pp = (d0 >> 4) & 1;
    for (int tile = b0_; tile < MROWS / 64; tile += gd_) {
        const int row0 = tile * 64; const int b = row0 / TT, t0 = row0 - b * TT;
        const bool lat = t0 >= CL;
        for (int i8 = 0; i8 < 8; ++i8) {
            const int tokl = wid * 8 + i8; const int t = t0 + tokl;
            bf16_t* zr = Z + (size_t)(row0 + tokl) * OD_IN;
            const u32x4 wq = *(const u32x4*)(zr + c8), wk = *(const u32x4*)(zr + 512 + (c8 & 127)), wvc = *(const u32x4*)(zr + 640 + (c8 & 127)), wqd = *(const u32x4*)(zr + 768 + c8), wvd = *(const u32x4*)(zr + 1792 + c8);
            const int tl = t - CL;
            const float pos = (float)(ax == 0 ? (tl >> 6) : (tl & 63));
            float cs[8], sn[8];
            if (lat) {
#pragma unroll
                for (int i = 0; i < 8; ++i) { const float ang = pos * inv[i]; cs[i] = __cosf(ang); sn[i] = __sinf(ang); } }
            float x[8], xp[8];
            unpack8(wq, x);
            { float ss = 0.f;
#pragma unroll
              for (int i = 0; i < 8; ++i) ss += x[i] * x[i];
              const float rs = rsqrtf(red8(ss) * (1.0f / 64.0f) + 1e-6f);
#pragma unroll
              for (int i = 0; i < 8; ++i) x[i] = x[i] * rs * qg[i]; }
            if (lat) {
#pragma unroll
                for (int i = 0; i < 8; ++i) { xp[i] = shx2(x[i]); }
#pragma unroll
                for (int i = 0; i < 8; ++i) x[i] = (pp == 0) ? (x[i] * cs[i] - xp[i] * sn[i]) : (xp[i] * sn[i] + x[i] * cs[i]); }
#pragma unroll
            for (int i = 0; i < 8; ++i) x[i] *= 0.18033688011112042f;
            *(u32x4*)(zr + c8) = pack8(x);
            float kx[8];
            unpack8(wk, kx);
            { float ss = 0.f;
#pragma unroll
              for (int i = 0; i < 8; ++i) ss += kx[i] * kx[i];
              const float rs = rsqrtf(red8(ss) * (1.0f / 64.0f) + 1e-6f);
#pragma unroll
              for (int i = 0; i < 8; ++i) kx[i] = kx[i] * rs * kg_[i]; }
            if (lat) {
#pragma unroll
                for (int i = 0; i < 8; ++i) { xp[i] = shx2(kx[i]); }
#pragma unroll
                for (int i = 0; i < 8; ++i) kx[i] = (pp == 0) ? (kx[i] * cs[i] - xp[i] * sn[i]) : (xp[i] * sn[i] + kx[i] * cs[i]); }
            if (lane < 16) {
                *(u32x4*)(zr + 512 + c8) = pack8(kx);
                bf16_t* vt = sVT + (size_t)c8 * 72 + tokl;
                vt[0] = (bf16_t)(wvc.x & 0xffff); vt[72] = (bf16_t)(wvc.x >> 16); vt[2 * 72] = (bf16_t)(wvc.y & 0xffff); vt[3 * 72] = (bf16_t)(wvc.y >> 16);
                vt[4 * 72] = (bf16_t)(wvc.z & 0xffff); vt[5 * 72] = (bf16_t)(wvc.z >> 16); vt[6 * 72] = (bf16_t)(wvc.w & 0xffff); vt[7 * 72] = (bf16_t)(wvc.w >> 16);
            }
            unpack8(wqd, x);
#pragma unroll
            for (int i = 0; i < 8; ++i) x[i] *= 0.18033688011112042f;
            *(u32x4*)(zr + 768 + c8) = pack8(x);
            { bf16_t* vt = sVT + (size_t)(128 + c8) * 72 + tokl;
              vt[0] = (bf16_t)(wvd.x & 0xffff); vt[72] = (bf16_t)(wvd.x >> 16); vt[2 * 72] = (bf16_t)(wvd.y & 0xffff); vt[3 * 72] = (bf16_t)(wvd.y >> 16);
              vt[4 * 72] = (bf16_t)(wvd.z & 0xffff); vt[5 * 72] = (bf16_t)(wvd.z >> 16); vt[6 * 72] = (bf16_t)(wvd.w & 0xffff); vt[7 * 72] = (bf16_t)(wvd.w >> 16); }
        }
        __syncthreads();
#pragma unroll
        for (int i = 0; i < 10; ++i) { const int id = tid + 512 * i, row = id >> 3, part = id & 7;
            const u32x4 w = *(const u32x4*)(sVT + row * 72 + part * 8);
            bf16_t* dst = (row < 128) ? VTG + ((size_t)(b * 2) * 64 + row) * TT : VTN + ((size_t)(b * 8) * 64 + (row - 128)) * TT;
            *(u32x4*)(dst + t0 + part * 8) = w; }
        __syncthreads();
    }
}

struct AttnTask { const bf16_t* Q; const bf16_t* Kd; const bf16_t* VTd; int nd; const bf16_t* Kn; const bf16_t* VTn; int nb; int r; int qc0; const float* rpb; bf16_t* Y; };
__device__ __forceinline__ void attn_load(const bf16_t* Kp, const bf16_t* VTp, bf16x8 (&Kf)[2][2], bf16x8 (&Vf)[4], int q, int g) {
#pragma unroll
    for (int kt = 0; kt < 2; ++kt)
#pragma unroll
        for (int ks = 0; ks < 2; ++ks) Kf[kt][ks] = *(const bf16x8*)(Kp + (size_t)(16 * kt + q) * OD_IN + 32 * ks + 8 * g);
#pragma unroll
    for (int dt = 0; dt < 4; ++dt) { const bf16_t* vp = VTp + (size_t)(16 * dt + q) * TT + 4 * g;
        const u32x2 lo = *(const u32x2*)vp, hi = *(const u32x2*)(vp + 16);
        u32x4 w; w.x = lo.x; w.y = lo.y; w.z = hi.x; w.w = hi.y; Vf[dt] = __builtin_bit_cast(bf16x8, w); }
}
__device__ __forceinline__ void attn_compute(const bf16x8 (&Kf)[2][2], const bf16x8 (&Vf)[4], const bf16x8 (&Qf)[2][2], f32x4 (&Oa)[2][4], float (&mrun)[2], float (&lrun)[2], int q, int g, bool nbr, int qc0, int cb, const float* brow, int a32) {
#pragma unroll
    for (int qt = 0; qt < 2; ++qt) {
        if (nbr && ((qc0 + 16 * qt == 0 && cb == 32) || (qc0 + 16 * qt == 48 && cb == 0))) continue;
        f32x4 S0 = {0.f, 0.f, 0.f, 0.f}, S1 = {0.f, 0.f, 0.f, 0.f};
#pragma unroll
        for (int ks = 0; ks < 2; ++ks) { S0 = __builtin_amdgcn_mfma_f32_16x16x32_bf16(Kf[0][ks], Qf[qt][ks], S0, 0, 0, 0); S1 = __builtin_amdgcn_mfma_f32_16x16x32_bf16(Kf[1][ks], Qf[qt][ks], S1, 0, 0, 0); }
        if (nbr) {
            const int c = qc0 + 16 * qt + q; int st = c - 8; st = st < 0 ? 0 : (st > 48 ? 48 : st);
#pragma unroll
            for (int i = 0; i < 4; ++i) { const int cw0 = cb + 4 * g + i, cw1 = cw0 + 16;
                S0[i] = (cw0 >= st && cw0 < st + 16) ? S0[i] + brow[cw0 - c + 15] : -200.f;
                S1[i] = (cw1 >= st && cw1 < st + 16) ? S1[i] + brow[cw1 - c + 15] : -200.f; }
        }
        float pv[8]; float ps = 0.f;
#pragma unroll
        for (int i = 0; i < 4; ++i) { pv[i] = __builtin_amdgcn_exp2f(fminf(S0[i], 80.f)); pv[4 + i] = __builtin_amdgcn_exp2f(fminf(S1[i], 80.f)); ps += pv[i] + pv[4 + i]; }
        lrun[qt] += ps;
        const bf16x8 Pq = __builtin_bit_cast(bf16x8, pack8(pv));
#pragma unroll
        for (int dt = 0; dt < 4; ++dt) Oa[qt][dt] = __builtin_amdgcn_mfma_f32_16x16x32_bf16(Vf[dt], Pq, Oa[qt][dt], 0, 0, 0);
    }
}
__device__ __forceinline__ void attn_wave(const AttnTask& t, int lane, int a32) {
    const int q = lane & 15, g = lane >> 4;
    bf16x8 Qf[2][2];
#pragma unroll
    for (int qt = 0; qt < 2; ++qt)
#pragma unroll
        for (int ks = 0; ks < 2; ++ks) Qf[qt][ks] = *(const bf16x8*)(t.Q + (size_t)(16 * qt + q) * OD_IN + 32 * ks + 8 * g);
    f32x4 Oa[2][4];
#pragma unroll
    for (int qt = 0; qt < 2; ++qt)
#pragma unroll
        for (int dt = 0; dt < 4; ++dt) Oa[qt][dt] = (f32x4){0.f, 0.f, 0.f, 0.f};
    float mrun[2] = {-1e30f, -1e30f}, lrun[2] = {0.f, 0.f};
    const int nds = t.nd >> 5, nsteps = nds + (t.nb == 1 ? 16 : 0);
    int rs = t.r - 4; rs = rs < 0 ? 0 : (rs > 24 ? 24 : rs);
    auto srcK = [&](int s) -> const bf16_t* { if (s < nds) return t.Kd + (size_t)s * 32 * OD_IN; const int u = s - nds; return t.Kn + (size_t)((rs + (u >> 1)) * 64 + (u & 1) * 32) * OD_IN; };
    auto srcV = [&](int s) -> const bf16_t* { if (s < nds) return t.VTd + s * 32; const int u = s - nds; return t.VTn + ((rs + (u >> 1)) * 64 + (u & 1) * 32); };
    bf16x8 KA[2][2], VA[4], KB[2][2], VB[4];
    attn_load(srcK(0), srcV(0), KA, VA, q, g);
    for (int s = 0; s < nsteps; s += 2) {
        attn_load(srcK(s + 1), srcV(s + 1), KB, VB, q, g);
        { const bool nbr = s >= nds; const int u = s - nds;
          attn_compute(KA, VA, Qf, Oa, mrun, lrun, q, g, nbr, t.qc0, (u & 1) * 32, t.rpb + (rs + (u >> 1) - t.r + 7) * 31, a32); }
        if (s + 2 < nsteps) attn_load(srcK(s + 2), srcV(s + 2), KA, VA, q, g);
        { const bool nbr = s + 1 >= nds; const int u = s + 1 - nds;
          attn_compute(KB, VB, Qf, Oa, mrun, lrun, q, g, nbr, t.qc0, (u & 1) * 32, t.rpb + (rs + (u >> 1) - t.r + 7) * 31, a32); }
    }
#pragma unroll
    for (int qt = 0; qt < 2; ++qt) {
        float l = lrun[qt]; l += shx16(l); l += shx32(l, a32);
        const float inv = 1.0f / l;
#pragma unroll
        for (int dt = 0; dt < 4; ++dt) { const f32x4 o = Oa[qt][dt] * inv; u32x2 w; w.x = pk2(o[0], o[1]); w.y = pk2(o[2], o[3]);
            *(u32x2*)(t.Y + (size_t)(16 * qt + q) * D + 16 * dt + 4 * g) = w; }
    }
}
__device__ __forceinline__ void gqa_block(const bf16_t* Qw, const bf16_t* Kd, const bf16_t* VTd, int nd, bf16_t* Yw, bf16_t* sKV, int tid, int lane, int a32) {
    const int q = lane & 15, g = lane >> 4;
    bf16x8 Qf[2][2];
#pragma unroll
    for (int qt = 0; qt < 2; ++qt)
#pragma unroll
        for (int ks = 0; ks < 2; ++ks) Qf[qt][ks] = *(const bf16x8*)(Qw + (size_t)(16 * qt + q) * OD_IN + 32 * ks + 8 * g);
    f32x4 Oa[2][4];
#pragma unroll
    for (int qt = 0; qt < 2; ++qt)
#pragma unroll
        for (int dt = 0; dt < 4; ++dt) Oa[qt][dt] = (f32x4){0.f, 0.f, 0.f, 0.f};
    float mrun[2] = {-1e30f, -1e30f}, lrun[2] = {0.f, 0.f};
    const int ntiles = nd >> 6;
    const int srow = tid >> 3, sch = (tid & 7) * 8;
    const bf16_t* kg_ = Kd + (size_t)srow * OD_IN + sch; const bf16_t* vg_ = VTd + (size_t)srow * TT + sch;
    bf16_t* sK = sKV; bf16_t* sV = sKV + 2 * 64 * 72;
    u32x4 pkA = *(const u32x4*)kg_, pvA = *(const u32x4*)vg_;
    u32x4 pkB = *(const u32x4*)(kg_ + (size_t)64 * OD_IN), pvB = *(const u32x4*)(vg_ + 64);
    __syncthreads();
    *(u32x4*)(sK + srow * 72 + sch) = pkA; *(u32x4*)(sV + srow * 72 + sch) = pvA;
    if (2 < ntiles) { pkA = *(const u32x4*)(kg_ + (size_t)2 * 64 * OD_IN); pvA = *(const u32x4*)(vg_ + 2 * 64); }
    __syncthreads();
    auto compute_tile = [&](int buf) {
        const bf16_t* bK = sK + buf * 64 * 72; const bf16_t* bV = sV + buf * 64 * 72;
#pragma unroll
        for (int ss = 0; ss < 2; ++ss) {
            bf16x8 Kf[2][2], Vf[4];
#pragma unroll
            for (int kt = 0; kt < 2; ++kt)
#pragma unroll
                for (int ks = 0; ks < 2; ++ks) Kf[kt][ks] = *(const bf16x8*)(bK + (32 * ss + 16 * kt + q) * 72 + 32 * ks + 8 * g);
#pragma unroll
            for (int dt = 0; dt < 4; ++dt) { const bf16_t* vp = bV + (16 * dt + q) * 72 + 32 * ss + 4 * g;
                const u32x2 lo = *(const u32x2*)vp, hi = *(const u32x2*)(vp + 16);
                u32x4 w; w.x = lo.x; w.y = lo.y; w.z = hi.x; w.w = hi.y; Vf[dt] = __builtin_bit_cast(bf16x8, w); }
            attn_compute(Kf, Vf, Qf, Oa, mrun, lrun, q, g, false, 0, 0, nullptr, a32);
        }
    };
    for (int i = 0; i < ntiles; i += 2) {
        compute_tile(0);
        *(u32x4*)(sK + 64 * 72 + srow * 72 + sch) = pkB; *(u32x4*)(sV + 64 * 72 + srow * 72 + sch) = pvB;
        if (i + 3 < ntiles) { pkB = *(const u32x4*)(kg_ + (size_t)(i + 3) * 64 * OD_IN); pvB = *(const u32x4*)(vg_ + (i + 3) * 64); }
        __syncthreads();
        compute_tile(1);
        if (i + 2 < ntiles) { *(u32x4*)(sK + srow * 72 + sch) = pkA; *(u32x4*)(sV + srow * 72 + sch) = pvA; }
        if (i + 4 < ntiles) { pkA = *(const u32x4*)(kg_ + (size_t)(i + 4) * 64 * OD_IN); pvA = *(const u32x4*)(vg_ + (i + 4) * 64); }
        __syncthreads();
    }
#pragma unroll
    for (int qt = 0; qt < 2; ++qt) {
        float l = lrun[qt]; l += shx16(l); l += shx32(l, a32);
        const float inv = 1.0f / l;
#pragma unroll
        for (int dt = 0; dt < 4; ++dt) { const f32x4 o = Oa[qt][dt] * inv; u32x2 w; w.x = pk2(o[0], o[1]); w.y = pk2(o[2], o[3]);
            *(u32x2*)(Yw + (size_t)(16 * qt + q) * D + 16 * dt + 4 * g) = w; }
    }
}
__device__ __forceinline__ void na_block(const bf16_t* Qw, const bf16_t* Kb, const bf16_t* VTb, int r, int hw, int qc0, const float* rpbh, bf16_t* Yw, bf16_t* sKV, int tid, int lane, int a32) {
    const int q = lane & 15, g = lane >> 4;
    bf16x8 Qf[2][2];
#pragma unroll
    for (int qt = 0; qt < 2; ++qt)
#pragma unroll
        for (int ks = 0; ks < 2; ++ks) Qf[qt][ks] = *(const bf16x8*)(Qw + (size_t)(16 * qt + q) * OD_IN + 32 * ks + 8 * g);
    f32x4 Oa[2][4];
#pragma unroll
    for (int qt = 0; qt < 2; ++qt)
#pragma unroll
        for (int dt = 0; dt < 4; ++dt) Oa[qt][dt] = (f32x4){0.f, 0.f, 0.f, 0.f};
    float mrun[2] = {0.f, 0.f}, lrun[2] = {0.f, 0.f};
    int rs = r - 4; rs = rs < 0 ? 0 : (rs > 24 ? 24 : rs);
    const int kh0 = tid >> 8, krow = (tid >> 3) & 31, kpart = (tid & 7) * 8;
    const int vrow = (tid >> 2) & 63, vpart = (tid & 3) * 8;
    const bf16_t* kg0 = Kb + (size_t)krow * OD_IN + kh0 * 64 + kpart; const bf16_t* vg0 = VTb + ((size_t)kh0 * 64 + vrow) * TT + vpart;
    bf16_t* sK = sKV; bf16_t* sV = sKV + 2 * 4 * 32 * 72;
    const int skoff = (kh0 * 32 + krow) * 72 + kpart, svoff = (kh0 * 64 + vrow) * 40 + vpart;
    auto koff = [&](int s) -> int { return s < 8 ? 32 * s : CL + (rs + ((s - 8) >> 1)) * 64 + ((s - 8) & 1) * 32; };
#define NA_LOAD(P, s) { const int ko_ = koff(s); P##k0 = *(const u32x4*)(kg0 + (size_t)ko_ * OD_IN); P##k1 = *(const u32x4*)(kg0 + (size_t)ko_ * OD_IN + 128); P##v0 = *(const u32x4*)(vg0 + ko_); P##v1 = *(const u32x4*)(vg0 + (size_t)128 * TT + ko_); }
#define NA_STORE(P, buf) { *(u32x4*)(sK + (buf) * 4 * 32 * 72 + skoff) = P##k0; *(u32x4*)(sK + (buf) * 4 * 32 * 72 + skoff + 2 * 32 * 72) = P##k1; \
        *(u32x4*)(sV + (buf) * 4 * 64 * 40 + svoff) = P##v0; *(u32x4*)(sV + (buf) * 4 * 64 * 40 + svoff + 2 * 64 * 40) = P##v1; }
    u32x4 Ak0, Ak1, Av0, Av1;
    NA_LOAD(A, 0)
    __syncthreads();
    NA_STORE(A, 0)
    NA_LOAD(A, 1)
    __syncthreads();
    auto compute_step = [&](int buf, int s) {
        const bf16_t* bK = sK + (buf * 4 + hw) * 32 * 72; const bf16_t* bV = sV + (buf * 4 + hw) * 64 * 40;
        bf16x8 Kf[2][2], Vf[4];
#pragma unroll
        for (int kt = 0; kt < 2; ++kt)
#pragma unroll
            for (int ks = 0; ks < 2; ++ks) Kf[kt][ks] = *(const bf16x8*)(bK + (16 * kt + q) * 72 + 32 * ks + 8 * g);
#pragma unroll
        for (int dt = 0; dt < 4; ++dt) { const bf16_t* vp = bV + (16 * dt + q) * 40 + 4 * g;
            const u32x2 lo = *(const u32x2*)vp, hi = *(const u32x2*)(vp + 16);
            u32x4 w; w.x = lo.x; w.y = lo.y; w.z = hi.x; w.w = hi.y; Vf[dt] = __builtin_bit_cast(bf16x8, w); }
        const int u = s - 8;
        attn_compute(Kf, Vf, Qf, Oa, mrun, lrun, q, g, s >= 8, qc0, (u & 1) * 32, rpbh + (rs + (u >> 1) - r + 7) * 31, a32);
    };
#pragma unroll 1
    for (int s = 0; s < 24; ++s) {
        const int buf = s & 1;
        compute_step(buf, s);
        if (s + 1 < 24) NA_STORE(A, buf ^ 1)
        if (s + 2 < 24) NA_LOAD(A, s + 2)
        __syncthreads();
    }
#undef NA_LOAD
#undef NA_STORE
#pragma unroll
    for (int qt = 0; qt < 2; ++qt) {
        float l = lrun[qt]; l += shx16(l); l += shx32(l, a32);
        const float inv = 1.0f / l;
#pragma unroll
        for (int dt = 0; dt < 4; ++dt) { const f32x4 o = Oa[qt][dt] * inv; u32x2 w; w.x = pk2(o[0], o[1]); w.y = pk2(o[2], o[3]);
            *(u32x2*)(Yw + (size_t)(16 * qt + q) * D + 16 * dt + 4 * g) = w; }
    }
}
__device__ __forceinline__ void odd_attn_phase(const Params& p, int j, bool need_ctx, const bf16_t* Z, const bf16_t* VTG, const bf16_t* VTN, bf16_t* Y, float* sRpb) {
    const int tid = tid_(), wid = __builtin_amdgcn_readfirstlane(tid >> 6), lane = tid & 63; const int b0_ = bid_(), gd_ = gdim_(); const int a32 = x32addr_();
    __syncthreads();
    { const float* prpb = inp(30) + (size_t)j * 8 * 465; for (int idx = tid; idx < 8 * 465; idx += 512) sRpb[idx] = prpb[idx] * 1.4426950408889634f; }
    __syncthreads();
    const int ntask = 4096 + (need_ctx ? 512 : 0);
    for (int task = b0_; task < ntask; task += gd_) {
        AttnTask t; t.nb = 0; t.Kn = nullptr; t.VTn = nullptr; t.r = 0; t.qc0 = 0; t.rpb = sRpb;
        if (task < 2048) {
            const int b = task >> 6, kvh = (task >> 5) & 1, qb = task & 31, hq = kvh * 4 + (wid >> 1), qh = wid & 1;
            const size_t row = (size_t)b * TT + CL + qb * 64 + qh * 32;
            t.Q = Z + row * OD_IN + hq * 64; t.Kd = Z + (size_t)b * TT * OD_IN + 512 + kvh * 64; t.VTd = VTG + (size_t)(b * 2 + kvh) * 64 * TT; t.nd = TT;
            t.Y = Y + row * D + hq * 64; t.nb = 2;
        } else if (task < 4096) {
            const int tk = task - 2048; const int b = tk >> 6, r = (tk >> 1) & 31, h = (tk & 1) * 4 + (wid >> 1), qh = wid & 1;
            const size_t row = (size_t)b * TT + CL + r * 64 + qh * 32;
            t.Q = Z + row * OD_IN + 768 + h * 64; t.Kd = Z + (size_t)b * TT * OD_IN + 1280 + h * 64; t.VTd = VTN + (size_t)(b * 8 + h) * 64 * TT; t.nd = CL;
            t.Kn = t.Kd + (size_t)CL * OD_IN; t.VTn = t.VTd + CL; t.nb = 1; t.r = r; t.qc0 = qh * 32; t.rpb = sRpb + h * 465;
            t.Y = Y + row * D + 512 + h * 64;
        } else if (task < 4352) {
            const int tk = task - 4096; const int b = tk >> 3, kvh = (tk >> 2) & 1, qb = tk & 3, hq = kvh * 4 + (wid >> 1), qh = wid & 1;
            const size_t row = (size_t)b * TT + qb * 64 + qh * 32;
            t.Q = Z + row * OD_IN + hq * 64; t.Kd = Z + (size_t)b * TT * OD_IN + 512 + kvh * 64; t.VTd = VTG + (size_t)(b * 2 + kvh) * 64 * TT; t.nd = CL;
            t.Y = Y + row * D + hq * 64; t.nb = 2;
        } else {
            const int tk = task - 4352; const int b = tk >> 3, qblk = tk & 7, h = wid;
            const size_t row = (size_t)b * TT + qblk * 32;
            t.Q = Z + row * OD_IN + 768 + h * 64; t.Kd = Z + (size_t)b * TT * OD_IN + 1280 + h * 64; t.VTd = VTN + (size_t)(b * 8 + h) * 64 * TT; t.nd = CL;
            t.Y = Y + row * D + 512 + h * 64;
        }
        if (t.nb == 2) gqa_block(t.Q, t.Kd, t.VTd, t.nd, t.Y, (bf16_t*)(sRpb + 4096), tid, lane, a32);
        else if (t.nb == 1) { const int tk = task - 2048; const int b = tk >> 6, hg4 = (tk & 1) * 4;
            na_block(t.Q, Z + (size_t)b * TT * OD_IN + 1280 + hg4 * 64, VTN + (size_t)(b * 8 + hg4) * 64 * TT, t.r, wid >> 1, t.qc0, t.rpb, t.Y, (bf16_t*)(sRpb + 4096), tid, lane, a32); }
        else attn_wave(t, lane, a32);
    }
}

#define XB_TMO      128
#define XB_XCNT(j)  (256  + 64 * (j))
#define XB_XSUB(j)  (1280 + 64 * (j))
#define XB_XGEN(j)  (2304 + 64 * (j))
#define XB_TOP      3328
#define XB_TOPGEN   3392
#define XCD_BAR_WORDS 3456
#define XB_SPIN_CAP (1u << 22)
__device__ __forceinline__ unsigned xb_ld(unsigned* p)              { return __hip_atomic_load(p, __ATOMIC_RELAXED, __HIP_MEMORY_SCOPE_AGENT); }
__device__ __forceinline__ unsigned xb_add(unsigned* p, unsigned v) { return __hip_atomic_fetch_add(p, v, __ATOMIC_RELAXED, __HIP_MEMORY_SCOPE_AGENT); }
__device__ __forceinline__ unsigned xb_xcc_id() { return (unsigned)__builtin_amdgcn_s_getreg((3 << 11) | 20) & 0xFu; }
#define XB_SPIN(cond, bar) do { unsigned _sp = 0; while (cond) { __builtin_amdgcn_s_sleep(1); \
    if ((++_sp & 255u) == 0u) { if (xb_ld(&(bar)[XB_TMO])) break; if (_sp > XB_SPIN_CAP) { atomicAdd(&(bar)[XB_TMO], 1u); break; } } } } while (0)
__device__ __forceinline__ void xcd_barrier_complete(unsigned* bar, unsigned x, unsigned& nloc, unsigned& nx) {
    const unsigned G = gridDim.x;
    unsigned sum, cnt, mine, sp = 0u;
    for (;;) {
        sum = 0u; cnt = 0u; mine = 0u;
#pragma unroll
        for (unsigned j = 0; j < 16; ++j) { const unsigned c = xb_ld(&bar[XB_XCNT(j)]); sum += c; cnt += (c > 0u) ? 1u : 0u; mine = (j == x) ? c : mine; }
        if (sum == G) break;
        __builtin_amdgcn_s_sleep(1);
        if ((++sp & 255u) == 0u) { if (xb_ld(&bar[XB_TMO])) break; if (sp > XB_SPIN_CAP) { atomicAdd(&bar[XB_TMO], 1u); break; } }
    }
    nloc = mine > 0u ? mine : 1u; nx = cnt > 0u ? cnt : 1u;
}
__device__ __forceinline__ void gbar(unsigned* bar, volatile LAS unsigned* st) {
    asm volatile("s_waitcnt vmcnt(0)" ::: "memory");
    __syncthreads();
    if (threadIdx.x == 0) {
        __builtin_amdgcn_s_waitcnt(0);
        const unsigned x = xb_xcc_id();
        unsigned nloc = st[0], nx = st[1];
        if (nloc == 0u) { xcd_barrier_complete(bar, x, nloc, nx); st[0] = nloc; st[1] = nx; }
        const unsigned old = xb_add(&bar[XB_XSUB(x)], 1u);
        const unsigned gen = old / nloc;
        if (old + 1u == (gen + 1u) * nloc) {
            __builtin_amdgcn_fence(__ATOMIC_RELEASE, "agent");
            asm volatile("s_waitcnt vmcnt(0)" ::: "memory");
            const unsigned og = xb_add(&bar[XB_TOP], 1u);
            const unsigned tg = og / nx;
            if (og + 1u == (tg + 1u) * nx) xb_add(&bar[XB_TOPGEN], 1u);
            else XB_SPIN(xb_ld(&bar[XB_TOPGEN]) == tg, bar);
            __builtin_amdgcn_fence(__ATOMIC_ACQUIRE, "agent");
            xb_add(&bar[XB_XGEN(x)], 1u);
            asm volatile("s_waitcnt vmcnt(0)" ::: "memory");
        } else {
            XB_SPIN(xb_ld(&bar[XB_XGEN(x)]) == gen, bar);
            __builtin_amdgcn_fence(__ATOMIC_ACQUIRE, "agent");
            asm volatile("s_waitcnt vmcnt(0)" ::: "memory");
        }
    }
    __syncthreads();
}
constexpr size_t OFF_BAR = OFF_MOD + 3670016;
__global__ void __launch_bounds__(512, 2) mega(Params p) {
    extern __shared__ __attribute__((aligned(16))) unsigned char lds_raw[];
    cg::grid_group grid = cg::this_grid();
    float* smf = (float*)lds_raw;
    LAS unsigned char* ldsg = (LAS unsigned char*)lds_raw;
    if (blockIdx.x == 0) { unsigned* bw = (unsigned*)(wsp() + OFF_BAR); for (int i = threadIdx.x; i < XCD_BAR_WORDS; i += 512) __hip_atomic_store(bw + i, 0u, __ATOMIC_RELAXED, __HIP_MEMORY_SCOPE_AGENT); }
    volatile LAS unsigned* bar_st = (volatile LAS unsigned*)(ldsg + LDS_BYTES - 16);
    if (threadIdx.x == 0) { bar_st[0] = 0u; bar_st[1] = 0u; }
    for (int l = 0; l < 4; ++l) {
        const int j = l >> 1; unsigned char* wl = wsp() + OFF_W + (size_t)l * WL_BYTES;
        if ((l & 1) == 0) { convert_matrix(inp(10) + (size_t)j * D * EV_IN, D, EV_IN, EV_INP, 0, (bf16_t*)(wl + WO_IN), smf);
                            convert_matrix(inp(11) + (size_t)j * D * D, D, D, D, 0, (bf16_t*)(wl + WO_OUT), smf); }
        else              { convert_matrix(inp(26) + (size_t)j * D * OD_IN, D, OD_IN, OD_IN, 0, (bf16_t*)(wl + WO_IN), smf);
                            convert_matrix(inp(27) + (size_t)j * D * D, D, D, D, 0, (bf16_t*)(wl + WO_OUT), smf); }
        convert_matrix(inp(8) + (size_t)l * D * NFF, D, NFF, NFF, 1, (bf16_t*)(wl + WO_W13), smf);
        convert_matrix(inp(9) + (size_t)l * DFF * D, DFF, D, D, 0, (bf16_t*)(wl + WO_W2), smf);
    }
    { const int b0_ = bid_(), gd_ = gdim_(); for (int item = b0_; item < 192; item += gd_) mod_item(p, item, smf, smf + 33 * 256); }
    grid.sync();
    if (threadIdx.x == 0) (void)xb_add(&((unsigned*)(wsp() + OFF_BAR))[XB_XCNT(xb_xcc_id())], 1u);

#define WS_ (wsp())
#define MODL_ ((const float*)(WS_ + OFF_MOD) + (size_t)l * 33 * 6144)
#define WL_ (WS_ + OFF_W + (size_t)l * WL_BYTES)
#define HB_ ((bf16_t*)(WS_ + OFF_H))
#define CTXX_ ((float*)(WS_ + OFF_CTXX))
    for (int l = 0; l < 4; ++l) {
        const int j = l >> 1; const bool even = (l & 1) == 0;
        norm_phase((l == 0) ? inp(0) : (const float*)outp(), (l == 0) ? inp(2) : (const float*)CTXX_, inp(6) + l * D, MODL_, 0, 1024, HB_);
        gbar((unsigned*)(wsp() + OFF_BAR), bar_st);
        if (even) {
            for (int hb = 0; hb < 2; ++hb) {
                { unsigned char* R = WS_ + OFF_R;
                  pg8::Gemm g{HB_ + (size_t)hb * HROWS * D, (const bf16_t*)(WL_ + WO_IN), HROWS, EV_INP, D};
                  pg8::StaticOrder S; S.init(HROWS, EV_INP, gdim_(), bid_());
                  EpiZ E{(bf16_t*)R, EV_INP};
                  pg8::gemm_phase<EpiZ>(ldsg, g, S, E); }
                gbar((unsigned*)(wsp() + OFF_BAR), bar_st);
                for (int rep_ = 0; rep_ < REP_FEAT; ++rep_) { unsigned char* R = WS_ + OFF_R; even_feat_phase(p, j, (const bf16_t*)R, (bf16_t*)(R + RO_F), smf); }
                gbar((unsigned*)(wsp() + OFF_BAR), bar_st);
                for (int rep_ = 0; rep_ < REP_RWKV; ++rep_) { unsigned char* R = WS_ + OFF_R; rwkv_scan_phase((const bf16_t*)(R + RO_F), (bf16_t*)(R + RO_O), smf); }
                for (int rep_ = 0; rep_ < REP_GLA; ++rep_) { unsigned char* R = WS_ + OFF_R; gla_phase(p, j, (const bf16_t*)R, (bf16_t*)(R + RO_O), smf); }
                gbar((unsigned*)(wsp() + OFF_BAR), bar_st);
                { unsigned char* R = WS_ + OFF_R; even_merge_phase(p, j, (const bf16_t*)R, (const bf16_t*)(R + RO_F), (const bf16_t*)(R + RO_O), HB_ + (size_t)hb * HROWS * D); }
                gbar((unsigned*)(wsp() + OFF_BAR), bar_st);
            }
        } else {
            { unsigned char* R = WS_ + OFF_R;
              pg8::Gemm g{HB_, (const bf16_t*)(WL_ + WO_IN), MROWS, OD_IN, D};
              pg8::StaticOrder S; S.init(MROWS, OD_IN, gdim_(), bid_());
              EpiZ E{(bf16_t*)R, OD_IN};
              pg8::gemm_phase<EpiZ>(ldsg, g, S, E); }
            gbar((unsigned*)(wsp() + OFF_BAR), bar_st);
            { unsigned char* R = WS_ + OFF_R; odd_feat_phase(p, j, (bf16_t*)R, (bf16_t*)(R + RO_VTG), (bf16_t*)(R + RO_VTN), smf); }
            gbar((unsigned*)(wsp() + OFF_BAR), bar_st);
            for (int rep_ = 0; rep_ < REP_ATTN; ++rep_) { unsigned char* R = WS_ + OFF_R; odd_attn_phase(p, j, l < 3, (const bf16_t*)R, (const bf16_t*)(R + RO_VTG), (const bf16_t*)(R + RO_VTN), HB_, smf); }
            gbar((unsigned*)(wsp() + OFF_BAR), bar_st);
        }
        { pg8::Gemm g{HB_, (const bf16_t*)(WL_ + WO_OUT), MROWS, D, D};
          pg8::StaticOrder S; S.init(MROWS, D, gdim_(), bid_(), l == 3);
          EpiRes E{(l == 0) ? inp(0) : (const float*)outp(), (l == 0) ? inp(2) : (const float*)CTXX_, outp(), CTXX_, MODL_, 2048};
          pg8::gemm_phase<EpiRes>(ldsg, g, S, E); }
        gbar((unsigned*)(wsp() + OFF_BAR), bar_st);
        norm_phase(outp(), CTXX_, inp(7) + l * D, MODL_, 3072, 4096, HB_);
        gbar((unsigned*)(wsp() + OFF_BAR), bar_st);
        for (int rep_ = 0; rep_ < REP_FFNUP; ++rep_) { pg8::Gemm g{HB_, (const bf16_t*)(WL_ + WO_W13), MROWS, NFF, D};
          pg8::StaticOrder S; S.init(MROWS, NFF, gdim_(), bid_(), l == 3);
          EpiSwi E{(bf16_t*)(WS_ + OFF_R)};
          pg8::gemm_phase<EpiSwi>(ldsg, g, S, E); }
        gbar((unsigned*)(wsp() + OFF_BAR), bar_st);
        { pg8::Gemm g{(const bf16_t*)(WS_ + OFF_R), (const bf16_t*)(WL_ + WO_W2), MROWS, D, DFF};
          pg8::StaticOrder S; S.init(MROWS, D, gdim_(), bid_(), l == 3);
          EpiRes E{outp(), CTXX_, outp(), CTXX_, MODL_, 5120};
          pg8::gemm_phase<EpiRes>(ldsg, g, S, E); }
        gbar((unsigned*)(wsp() + OFF_BAR), bar_st);
    }
    float* xfin = outp(); const float* gfin = inp(31);
    const int tid = tid_(), lane = tid & 63, gw = bid_() * 8 + (tid >> 6), nw = gdim_() * 8; const int a32 = x32addr_();
    for (int r4 = gw; r4 < NB * TL / 4; r4 += nw) {
        float* xr = xfin + (size_t)r4 * 4 * D;
        f32x4 v[4][4];
#pragma unroll
        for (int rr = 0; rr < 4; ++rr)
#pragma unroll
            for (int i = 0; i < 4; ++i) v[rr][i] = *(const f32x4*)(xr + (size_t)rr * D + i * 256 + lane * 4);
        f32x4 gg[4];
#pragma unroll
        for (int i = 0; i < 4; ++i) gg[i] = *(const f32x4*)(gfin + i * 256 + lane * 4);
#pragma unroll
        for (int rr = 0; rr < 4; ++rr) {
            float ss = 0.f;
#pragma unroll
            for (int i = 0; i < 4; ++i) ss += v[rr][i][0] * v[rr][i][0] + v[rr][i][1] * v[rr][i][1] + v[rr][i][2] * v[rr][i][2] + v[rr][i][3] * v[rr][i][3];
            ss = red64(ss, a32);
            const float rs = rsqrtf(ss * (1.0f / 1024.0f) + 1e-6f);
#pragma unroll
            for (int i = 0; i < 4; ++i) *(f32x4*)(xr + (size_t)rr * D + i * 256 + lane * 4) = v[rr][i] * rs * gg[i];
        }
    }
}

extern "C" void kernel_launch(void* const* d_in, const int* in_sizes, int n_in, void* d_out, int out_size, void* d_ws, size_t ws_size, hipStream_t stream) {
    static int grid_blocks = 0;
    if (!grid_blocks) {
        int dev = 0, cus = 0, per_cu = 0;
        (void)hipGetDevice(&dev);
        (void)hipDeviceGetAttribute(&cus, hipDeviceAttributeMultiprocessorCount, dev);
        (void)hipFuncSetAttribute((const void*)mega, hipFuncAttributeMaxDynamicSharedMemorySize, LDS_BYTES);
        (void)hipOccupancyMaxActiveBlocksPerMultiprocessor(&per_cu, (const void*)mega, 512, LDS_BYTES);
        if (per_cu < 1) per_cu = 1;
        grid_blocks = cus * per_cu;
        if (ws_size < WS_NEED || n_in != 32) { fprintf(stderr, "kernel_launch: workspace %zu < %zu or n_in %d != 32\n", ws_size, (size_t)WS_NEED, n_in); grid_blocks = -1; }
    }
    if (grid_blocks < 0) return;
    Params p{};
    for (int i = 0; i < 32; ++i) p.in[i] = (const float*)d_in[i];
    p.out = (float*)d_out; p.ws = (unsigned char*)d_ws;
    void* args[] = {&p};
    hipError_t e = hipLaunchCooperativeKernel((void*)mega, dim3(grid_blocks), dim3(512), args, LDS_BYTES, stream);
    if (e != hipSuccess) fprintf(stderr, "cooperative launch failed: %s (grid %d)\n", hipGetErrorString(e), grid_blocks);
}
```

```cpp
#include <hip/hip_runtime.h>
#include <hip/hip_cooperative_groups.h>
#include <cstdio>
namespace cg = cooperative_groups;

#define LAS __attribute__((address_space(3)))
typedef unsigned short bf16_t;
typedef short bf16x8 __attribute__((ext_vector_type(8)));
typedef float f32x4 __attribute__((ext_vector_type(4)));
typedef float f32x2 __attribute__((ext_vector_type(2)));
typedef unsigned u32x4 __attribute__((ext_vector_type(4)));
typedef unsigned u32x2 __attribute__((ext_vector_type(2)));

constexpr int D = 1024, NB = 32, TL = 2048, CL = 256, TT = 2304, MROWS = NB * TT, HROWS = MROWS / 2;
constexpr int EV_IN = 3296, EV_INP = 3328, OD_IN = 2304, DFF = 2816, NFF = 5632;
constexpr int LDS_BYTES = 144 * 1024;
#ifndef REP_ATTN
#define REP_ATTN 1
#endif
#ifndef REP_RWKV
#define REP_RWKV 1
#endif
#ifndef REP_GLA
#define REP_GLA 1
#endif
#ifndef REP_FEAT
#define REP_FEAT 1
#endif
#ifndef REP_FFNUP
#define REP_FFNUP 1
#endif
constexpr size_t OFF_CTXX = 0, OFF_MOD = 33554432, OFF_W = 37748736, WL_BYTES = 26214400, OFF_H = 142606336, OFF_R = 293601280;
constexpr size_t WO_IN = 0, WO_OUT = 6815744, WO_W13 = 8912896, WO_W2 = 20447232;
constexpr size_t RO_F = 245366784, RO_O = 547356672;
constexpr size_t RO_VTG = 339738624, RO_VTN = 358612992;
constexpr size_t WS_NEED = OFF_R + 698351616;

struct Params { const float* in[32]; float* out; unsigned char* ws; };
typedef const __attribute__((address_space(4))) char* kaptr_t;
__device__ __forceinline__ kaptr_t kabase() { kaptr_t ka = (kaptr_t)__builtin_amdgcn_kernarg_segment_ptr(); asm volatile("" : "+s"(ka)); return ka; }
__device__ __forceinline__ const float* inp(int i) { return *(const float* const __attribute__((address_space(4)))*)(kabase() + 8 * i); }
__device__ __forceinline__ float* outp() { return *(float* const __attribute__((address_space(4)))*)(kabase() + 256); }
__device__ __forceinline__ unsigned char* wsp() { return *(unsigned char* const __attribute__((address_space(4)))*)(kabase() + 264); }

typedef float cvt_f32x2_t __attribute__((ext_vector_type(2)));
typedef __bf16 cvt_bf16x2_t __attribute__((ext_vector_type(2)));
__device__ __forceinline__ unsigned pk2(float lo, float hi) { const cvt_f32x2_t v = {lo, hi}; const cvt_bf16x2_t b = __builtin_convertvector(v, cvt_bf16x2_t); return __builtin_bit_cast(unsigned, b); }
__device__ __forceinline__ unsigned f2bf(float f) { return pk2(f, f) & 0xffffu; }
__device__ __forceinline__ float bflo(unsigned u) { return __builtin_bit_cast(float, u << 16); }
__device__ __forceinline__ float bfhi(unsigned u) { return __builtin_bit_cast(float, u & 0xffff0000u); }
__device__ __forceinline__ float bf1(bf16_t b) { return __builtin_bit_cast(float, ((unsigned)b) << 16); }
__device__ __forceinline__ void unpack8(u32x4 w, float* o) { o[0] = bflo(w.x); o[1] = bfhi(w.x); o[2] = bflo(w.y); o[3] = bfhi(w.y); o[4] = bflo(w.z); o[5] = bfhi(w.z); o[6] = bflo(w.w); o[7] = bfhi(w.w); }
__device__ __forceinline__ u32x4 pack8(const float* v) { u32x4 w; w.x = pk2(v[0], v[1]); w.y = pk2(v[2], v[3]); w.z = pk2(v[4], v[5]); w.w = pk2(v[6], v[7]); return w; }
__device__ __forceinline__ int tid_() { int t = threadIdx.x; asm volatile("" : "+v"(t)); return t; }
__device__ __forceinline__ int bid_() { int t = blockIdx.x; asm volatile("" : "+s"(t)); return t; }
__device__ __forceinline__ int gdim_() { int t = gridDim.x; asm volatile("" : "+s"(t)); return t; }
__device__ __forceinline__ float sigmoidf_(float x) { return __builtin_amdgcn_rcpf(1.0f + __expf(-x)); }
__device__ __forceinline__ float siluf_(float x) { return x * __builtin_amdgcn_rcpf(1.0f + __expf(-x)); }
template <int CTRL> __device__ __forceinline__ float dppf(float x) { return __builtin_bit_cast(float, __builtin_amdgcn_mov_dpp(__builtin_bit_cast(int, x), CTRL, 0xf, 0xf, true)); }
__device__ __forceinline__ float red8(float x) { x += dppf<0xB1>(x); x += dppf<0x4E>(x); x += dppf<0x141>(x); return x; }
__device__ __forceinline__ int x32addr_() { int l = __builtin_amdgcn_mbcnt_hi(-1, __builtin_amdgcn_mbcnt_lo(-1, 0)); asm volatile("" : "+v"(l)); return (l ^ 32) << 2; }
__device__ __forceinline__ float shx2(float x) { return dppf<0x4E>(x); }
__device__ __forceinline__ float shx8(float x) { return dppf<0x128>(x); }
__device__ __forceinline__ float shx16(float x) { return __builtin_bit_cast(float, __builtin_amdgcn_ds_swizzle(__builtin_bit_cast(int, x), 0x401F)); }
__device__ __forceinline__ float shx32(float x, int a32) { return __builtin_bit_cast(float, __builtin_amdgcn_ds_bpermute(a32, __builtin_bit_cast(int, x))); }
__device__ __forceinline__ float red16(float x) { x = red8(x); x += shx8(x); return x; }
__device__ __forceinline__ float red64(float x, int a32) { x = red16(x); x += shx16(x); x += shx32(x, a32); return x; }

namespace pg8 {
constexpr int BM = 256, BK = 64, HALF = 128, HTB = HALF * BK * 2, STAGE_BYTES = 8 * HTB, NXCD = 8, WGM = 8;
__device__ __forceinline__ int lds_byte(int r, int c) { const int st = (r >> 4) * 2 + (c >> 5), rr = r & 15, cc = c & 31, ob = rr * 64 + cc * 2; return st * 1024 + (ob ^ (((ob >> 9) & 1) << 5)); }
__device__ __forceinline__ void stage_rc(int b, int& R, int& C) { const int st = b / 1024, sb = b % 1024, swz = sb ^ (((sb >> 9) & 1) << 5); R = (st >> 1) * 16 + swz / 64; C = (st & 1) * 32 + (swz % 64) / 2; }
__device__ __forceinline__ int perm32(int rho) { const int n = rho >> 4, i = rho & 15; return 8 * (i >> 2) + 4 * n + (i & 3); }
struct Unit { int pm, pn; };
struct Gemm { const bf16_t* A; const bf16_t* Bt; int M, N, K; };
struct StaticOrder {
    int nM, nN, nwg, G, c, skip;
    __device__ void init(int M, int N, int G_, int c_, int skip_ = 0) { skip = skip_; nM = skip_ ? NB * 8 : M / BM; nN = N / BM; nwg = nM * nN; G = G_; c = c_; }
    __device__ bool next(int i, Unit& u) const {
        const long L = (long)i * G + c; if (L >= nwg) return false;
        int wgid = (int)L; { const int q = nwg / NXCD, r = nwg % NXCD, xcd = wgid % NXCD, off = wgid / NXCD; wgid = (xcd < r ? xcd * (q + 1) : r * (q + 1) + (xcd - r) * q) + off; }
        const int nig = WGM * nN, gid = wgid / nig, fm = gid * WGM, gsz = (nM - fm) < WGM ? (nM - fm) : WGM;
        u.pm = fm + ((wgid % nig) % gsz); u.pn = (wgid % nig) / gsz; if (skip) u.pm = (u.pm >> 3) * 9 + 1 + (u.pm & 7); return true;
    }
};
template <class Epi>
__device__ __forceinline__ void gemm_phase(LAS unsigned char* lds, const Gemm g, const StaticOrder& S, const Epi& E) {
    const int tid = tid_(), wid = __builtin_amdgcn_readfirstlane(tid >> 6), lane = tid & 63, wr = wid >> 2, wc = wid & 3, fr = lane & 15, fq = lane >> 4;
    const int K = g.K, nt = K / BK;
    unsigned voffA[2], voffB[2];
#pragma unroll
    for (int i = 0; i < 2; ++i) { int R, C; stage_rc(tid * 16 + i * 8192, R, C); const int Rb = Epi::PERM ? ((R & ~31) + perm32(R & 31)) : R;
        voffA[i] = (unsigned)(R * K + C) * 2u; voffB[i] = (unsigned)(Rb * K + C) * 2u; }
    const size_t kstep = (size_t)(BK * 2);
    const size_t hstep = (size_t)HALF * K * 2;
    const size_t tstep = 2 * hstep;
    const unsigned ldsw = (unsigned)wid * 1024u;
    const int aoff = lds_byte(wr * 64 + fr, fq * 8), boff = lds_byte(wc * 32 + fr, fq * 8);
#define PG8_SA(b, h) (((b) * 2 + (h)) * HTB)
#define PG8_SB(b, h) ((4 + (b) * 2 + (h)) * HTB)
#define PG8_STAGE(bufoff, gbase, voff) do { _Pragma("unroll") for (int _i = 0; _i < 2; ++_i) \
        __builtin_amdgcn_global_load_lds((const unsigned*)((const char*)(gbase) + (voff)[_i]), (LAS unsigned*)(lds + (bufoff) + ldsw + _i * 8192), 16, 0, 0); } while (0)
#define PG8_LDA(dst, b, h) do { _Pragma("unroll") for (int m = 0; m < 4; ++m) _Pragma("unroll") for (int k = 0; k < 2; ++k) dst[m][k] = *(const LAS bf16x8*)(lds + PG8_SA(b, h) + aoff + m * 2048 + k * 1024); } while (0)
#define PG8_LDB(dst, b, h) do { _Pragma("unroll") for (int n = 0; n < 2; ++n) _Pragma("unroll") for (int k = 0; k < 2; ++k) dst[n][k] = *(const LAS bf16x8*)(lds + PG8_SB(b, h) + boff + n * 2048 + k * 1024); } while (0)
#define PG8_MMA(ai, bj, At, Bt) do { __builtin_amdgcn_s_setprio(1); _Pragma("unroll") for (int m = 0; m < 4; ++m) _Pragma("unroll") for (int n = 0; n < 2; ++n) _Pragma("unroll") for (int k = 0; k < 2; ++k) \
        acc[ai][bj][m][n] = __builtin_amdgcn_mfma_f32_16x16x32_bf16(Bt[n][k], At[m][k], acc[ai][bj][m][n], 0, 0, 0); __builtin_amdgcn_s_setprio(0); } while (0)
#define PG8_WAIT_V(n) asm volatile("s_waitcnt vmcnt(" #n ")" ::: "memory")
#define PG8_WAIT_L(n) asm volatile("s_waitcnt lgkmcnt(" #n ")" ::: "memory")
#define PG8_BAR __builtin_amdgcn_s_barrier()
#define PG8_SCHED __builtin_amdgcn_sched_barrier(0)
    Unit cur, nxt; int ui = 0;
    if (!S.next(0, cur)) return;
    f32x4 acc[2][2][4][2];
#pragma unroll
    for (int a = 0; a < 2; ++a)
#pragma unroll
        for (int b = 0; b < 2; ++b)
#pragma unroll
            for (int m = 0; m < 4; ++m)
#pragma unroll
                for (int n = 0; n < 2; ++n) acc[a][b][m][n] = (f32x4){0.f, 0.f, 0.f, 0.f};
    bf16x8 At[4][2], B0[2][2], B1[2][2];
    const char* cA = (const char*)g.A + (size_t)cur.pm * tstep; const char* cB = (const char*)g.Bt + (size_t)cur.pn * tstep;
    PG8_STAGE(PG8_SB(0, 0), cB, voffB); PG8_STAGE(PG8_SB(0, 1), cB + hstep, voffB); PG8_STAGE(PG8_SA(0, 0), cA, voffA); PG8_STAGE(PG8_SA(0, 1), cA + hstep, voffA);
    if (wr == 1) PG8_BAR;
    PG8_WAIT_V(2); PG8_BAR;
    PG8_STAGE(PG8_SB(1, 0), cB + kstep, voffB); PG8_STAGE(PG8_SA(1, 0), cA + kstep, voffA); PG8_STAGE(PG8_SB(1, 1), cB + hstep + kstep, voffB);
    PG8_WAIT_V(6); PG8_BAR;
    for (;;) {
        const bool has_next = S.next(ui + 1, nxt);
        const char* nA = has_next ? (const char*)g.A + (size_t)nxt.pm * tstep : cA; const char* nB = has_next ? (const char*)g.Bt + (size_t)nxt.pn * tstep : cB;
        for (int t = 0; t < nt; t += 2) {
            const bool last = (t == nt - 2);
            const char* a1 = cA + (size_t)(t + 1) * kstep;
            const char* a2 = last ? nA : cA + (size_t)(t + 2) * kstep; const char* b2 = last ? nB : cB + (size_t)(t + 2) * kstep;
            const char* a3 = a2 + kstep; const char* b3 = b2 + kstep;
            PG8_LDB(B0, 0, 0); PG8_LDB(B1, 0, 1); PG8_SCHED; PG8_LDA(At, 0, 0); PG8_STAGE(PG8_SA(1, 1), a1 + hstep, voffA);
            PG8_WAIT_V(8); PG8_WAIT_L(0); PG8_BAR; PG8_MMA(0, 0, At, B0); PG8_MMA(0, 1, At, B1); PG8_BAR; PG8_SCHED;
            PG8_LDA(At, 0, 1); PG8_STAGE(PG8_SB(0, 0), b2, voffB); PG8_STAGE(PG8_SB(0, 1), b2 + hstep, voffB); PG8_STAGE(PG8_SA(0, 0), a2, voffA);
            PG8_WAIT_V(8); PG8_WAIT_L(0); PG8_BAR; PG8_MMA(1, 0, At, B0); PG8_MMA(1, 1, At, B1); PG8_BAR; PG8_SCHED;
            PG8_LDB(B0, 1, 0); PG8_LDB(B1, 1, 1); PG8_SCHED; PG8_LDA(At, 1, 0); PG8_STAGE(PG8_SA(0, 1), a2 + hstep, voffA);
            PG8_WAIT_V(8); PG8_WAIT_L(0); PG8_BAR; PG8_MMA(0, 0, At, B0); PG8_MMA(0, 1, At, B1); PG8_BAR; PG8_SCHED;
            PG8_LDA(At, 1, 1); PG8_STAGE(PG8_SB(1, 0), b3, voffB); PG8_STAGE(PG8_SB(1, 1), b3 + hstep, voffB); PG8_STAGE(PG8_SA(1, 0), a3, voffA);
            PG8_WAIT_V(8); PG8_WAIT_L(0); PG8_BAR; PG8_MMA(1, 0, At, B0); PG8_MMA(1, 1, At, B1); PG8_BAR; PG8_SCHED;
        }
        if (wr == 0) PG8_BAR;
        E(acc, cur, wr, wc, fr, fq);
        if (!has_next) break;
#pragma unroll
        for (int a = 0; a < 2; ++a)
#pragma unroll
            for (int b = 0; b < 2; ++b)
#pragma unroll
                for (int m = 0; m < 4; ++m)
#pragma unroll
                    for (int n = 0; n < 2; ++n) acc[a][b][m][n] = (f32x4){0.f, 0.f, 0.f, 0.f};
        cur = nxt; cA = nA; cB = nB; ++ui;
        if (wr == 1) PG8_BAR;
    }
    PG8_WAIT_V(0);
    PG8_BAR;
#undef PG8_SA
#undef PG8_SB
#undef PG8_STAGE
#undef PG8_LDA
#undef PG8_LDB
#undef PG8_MMA
#undef PG8_WAIT_V
#undef PG8_WAIT_L
#undef PG8_BAR
#undef PG8_SCHED
}
}

struct EpiZ {
    static constexpr bool PERM = true;
    bf16_t* O; int ldc;
    __device__ __forceinline__ void operator()(const f32x4 (&acc)[2][2][4][2], const pg8::Unit& u, int wr, int wc, int fr, int fq) const {
        const int row0 = u.pm * 256 + wr * 64 + fr, col0 = u.pn * 256 + wc * 32 + 8 * fq;
#pragma unroll
        for (int ai = 0; ai < 2; ++ai)
#pragma unroll
            for (int m = 0; m < 4; ++m) { bf16_t* rowp = O + (size_t)(row0 + ai * 128 + m * 16) * ldc + col0;
#pragma unroll
                for (int bj = 0; bj < 2; ++bj) { const f32x4 v0 = acc[ai][bj][m][0], v1 = acc[ai][bj][m][1];
                    u32x4 w; w.x = pk2(v0[0], v0[1]); w.y = pk2(v0[2], v0[3]); w.z = pk2(v1[0], v1[1]); w.w = pk2(v1[2], v1[3]);
                    *(u32x4*)(rowp + bj * 128) = w; } }
    }
};
struct EpiSwi {
    static constexpr bool PERM = true;
    bf16_t* O;
    __device__ __forceinline__ void operator()(const f32x4 (&acc)[2][2][4][2], const pg8::Unit& u, int wr, int wc, int fr, int fq) const {
        const int row0 = u.pm * 256 + wr * 64 + fr, col0 = u.pn * 128 + wc * 32 + 8 * fq;
#pragma unroll
        for (int ai = 0; ai < 2; ++ai)
#pragma unroll
            for (int m = 0; m < 4; ++m) { bf16_t* rowp = O + (size_t)(row0 + ai * 128 + m * 16) * DFF + col0;
                float h[8];
#pragma unroll
                for (int n = 0; n < 2; ++n)
#pragma unroll
                    for (int j = 0; j < 4; ++j) h[n * 4 + j] = siluf_(acc[ai][0][m][n][j]) * acc[ai][1][m][n][j];
                *(u32x4*)rowp = pack8(h); }
    }
};
struct EpiRes {
    static constexpr bool PERM = false;
    const float* xin_l; const float* xin_c; float* xout_l; float* xout_c; const float* modl; int goff;
    __device__ __forceinline__ void operator()(const f32x4 (&acc)[2][2][4][2], const pg8::Unit& u, int wr, int wc, int fr, int fq) const {
        const int b = u.pm / 9, j = u.pm - 9 * b;
        const float* xi; float* xo; const float* gv;
        if (j == 0) { const size_t off = (size_t)b * CL * D; xi = xin_c + off; xo = xout_c + off; gv = modl + 32 * 6144 + goff; }
        else { const size_t off = ((size_t)b * TL + (size_t)(j - 1) * 256) * D; xi = xin_l + off; xo = xout_l + off; gv = modl + b * 6144 + goff; }
        const int rl0 = wr * 64 + fr, col0 = u.pn * 256 + wc * 32 + 4 * fq;
        f32x4 gate[2][2];
#pragma unroll
        for (int bj = 0; bj < 2; ++bj)
#pragma unroll
            for (int n = 0; n < 2; ++n) gate[bj][n] = *(const f32x4*)(gv + col0 + bj * 128 + n * 16);
#pragma unroll
        for (int ai = 0; ai < 2; ++ai)
#pragma unroll
            for (int m = 0; m < 4; ++m) { const size_t ro = (size_t)(rl0 + ai * 128 + m * 16) * D + col0;
#pragma unroll
                for (int bj = 0; bj < 2; ++bj)
#pragma unroll
                    for (int n = 0; n < 2; ++n) { const f32x4 xv = *(const f32x4*)(xi + ro + bj * 128 + n * 16);
                        *(f32x4*)(xo + ro + bj * 128 + n * 16) = xv + gate[bj][n] * acc[ai][bj][m][n]; } }
    }
};

__device__ __forceinline__ void convert_matrix(const float* W, int K, int N, int Np, int mode, bf16_t* Bt, float* sT) {
    const int ntiles = (Np >> 6) * (K >> 6);
    const int b0_ = bid_(), gd_ = gdim_();
    const int tid = tid_(), kr = tid >> 3, c8 = (tid & 7) * 8;
    const int nK = K >> 6;
    for (int t0 = b0_; t0 < ntiles; t0 += 4 * gd_) {
        float4 v0[4], v1[4]; int n0a[4], k0a[4];
#pragma unroll
        for (int u = 0; u < 4; ++u) { const int tile = t0 + u * gd_; v0[u] = (float4){0.f, 0.f, 0.f, 0.f}; v1[u] = v0[u]; n0a[u] = 0; k0a[u] = 0;
            if (tile < ntiles) { const int nt = tile / nK, kt = tile - nt * nK; const int n0 = nt * 64, k0 = kt * 64; n0a[u] = n0; k0a[u] = k0;
                int src0 = n0;
                if (mode == 1) { const int pn = n0 >> 8, rem = n0 & 255, half = rem >> 7, jj = rem & 127; src0 = half * DFF + pn * 128 + jj; }
                const float* src = W + (size_t)(k0 + kr) * N + src0 + c8;
                if (src0 + c8 < N) { v0[u] = *(const float4*)src; v1[u] = *(const float4*)(src + 4); } } }
#pragma unroll
        for (int u = 0; u < 4; ++u) { const int tile = t0 + u * gd_;
            if (tile < ntiles) {
                float* d = sT + kr * 65 + c8;
                d[0] = v0[u].x; d[1] = v0[u].y; d[2] = v0[u].z; d[3] = v0[u].w; d[4] = v1[u].x; d[5] = v1[u].y; d[6] = v1[u].z; d[7] = v1[u].w;
                __syncthreads();
                const int nr = tid >> 3, kg = (tid & 7) * 8;
                float o[8];
#pragma unroll
                for (int jj = 0; jj < 8; ++jj) o[jj] = sT[(kg + jj) * 65 + nr];
                *(u32x4*)(Bt + (size_t)(n0a[u] + nr) * K + k0a[u] + kg) = pack8(o);
                __syncthreads(); } }
    }
}
__device__ __forceinline__ void mod_item(const Params& p, int item, float* sS, float* sRed) {
    const int l = item / 48, cb = item - l * 48; const int tid = tid_(), c = tid & 127, kq = tid >> 7;
    const float* wm = inp(4) + (size_t)l * 1024 * 6144 + cb * 128 + c; const float* cvec = inp(1); const float* cctx = inp(3); const float* bmod = inp(5);
    float acc[33];
#pragma unroll
    for (int r = 0; r < 33; ++r) acc[r] = 0.f;
    for (int kc = 0; kc < 4; ++kc) {
        __syncthreads();
        for (int idx = tid; idx < 33 * 256; idx += 512) { const int r = idx >> 8, k = kc * 256 + (idx & 255);
            const float cv = (r < 32) ? cvec[r * 1024 + k] : cctx[k]; sS[idx] = siluf_(cv); }
        __syncthreads();
        for (int kk = 0; kk < 64; kk += 8) { const int kl = kq * 64 + kk; float w[8];
#pragma unroll
            for (int u = 0; u < 8; ++u) w[u] = wm[(size_t)(kc * 256 + kl + u) * 6144];
#pragma unroll
            for (int u = 0; u < 8; ++u)
#pragma unroll
                for (int r = 0; r < 33; ++r) acc[r] += sS[r * 256 + kl + u] * w[u]; }
    }
#pragma unroll
    for (int r = 0; r < 33; ++r) sRed[(kq * 33 + r) * 128 + c] = acc[r];
    __syncthreads();
    float* mod = (float*)(wsp() + OFF_MOD);
    for (int idx = tid; idx < 33 * 128; idx += 512) { const int r = idx >> 7, cc = idx & 127;
        float v = bmod[l * 6144 + cb * 128 + cc];
#pragma unroll
        for (int q = 0; q < 4; ++q) v += sRed[(q * 33 + r) * 128 + cc];
        mod[(size_t)(l * 33 + r) * 6144 + cb * 128 + cc] = v; }
    __syncthreads();
}

__device__ __forceinline__ void norm_phase(const float* xl, const float* xc, const float* g, const float* modl, int sh_off, int sc_off, bf16_t* H) {
    const int tid = tid_(), lane = tid & 63, gw = bid_() * 8 + (tid >> 6), nw = gdim_() * 8; const int a32 = x32addr_();
    for (int r4 = gw; r4 < MROWS / 4; r4 += nw) {
        const int row = r4 * 4; const int b = row / TT, t = row - b * TT;
        const float* src = (t < CL) ? xc + ((size_t)b * CL + t) * D : xl + ((size_t)b * TL + (t - CL)) * D;
        const float* mv = modl + (size_t)((t < CL) ? 32 : b) * 6144;
        f32x4 v[4][4];
#pragma unroll
        for (int rr = 0; rr < 4; ++rr)
#pragma unroll
            for (int i = 0; i < 4; ++i) v[rr][i] = *(const f32x4*)(src + (size_t)rr * D + i * 256 + lane * 4);
        f32x4 mul[4], sh[4];
#pragma unroll
        for (int i = 0; i < 4; ++i) { const int c = i * 256 + lane * 4; mul[i] = *(const f32x4*)(g + c) * (*(const f32x4*)(mv + sc_off + c) + 1.0f); sh[i] = *(const f32x4*)(mv + sh_off + c); }
#pragma unroll
        for (int rr = 0; rr < 4; ++rr) {
            float ss = 0.f;
#pragma unroll
            for (int i = 0; i < 4; ++i) ss += v[rr][i][0] * v[rr][i][0] + v[rr][i][1] * v[rr][i][1] + v[rr][i][2] * v[rr][i][2] + v[rr][i][3] * v[rr][i][3];
            ss = red64(ss, a32);
            const float rs = rsqrtf(ss * (1.0f / 1024.0f) + 1e-6f);
#pragma unroll
            for (int i = 0; i < 4; ++i) { const f32x4 y = v[rr][i] * rs * mul[i] + sh[i];
                u32x2 w; w.x = pk2(y[0], y[1]); w.y = pk2(y[2], y[3]);
                *(u32x2*)(H + (size_t)(row + rr) * D + i * 256 + lane * 4) = w; }
        }
    }
}

__device__ __forceinline__ float shift3(float z, float pv, float nx, float m0, float m1) { return z + m0 * (pv - z) + m1 * (nx - z); }
__device__ __forceinline__ void even_feat_phase(const Params& p, int j, const bf16_t* Z, bf16_t* F, float* sm) {
    constexpr int WS = 104;
    const int tid = tid_(), lane = tid & 63, w = __builtin_amdgcn_readfirstlane(tid >> 6), q = lane & 15, g = lane >> 4;
    bf16_t* sLR = (bf16_t*)sm;
    bf16_t* sWT = sLR + 2 * 16 * WS;
    const float* mu = inp(15) + (size_t)j * 2 * 1728;
    const int b0_ = bid_(), gd_ = gdim_();
    int lj[3], ltk[3];
#pragma unroll
    for (int u = 0; u < 3; ++u) { const int idx = tid + 512 * u; lj[u] = idx >> 4; ltk[u] = idx & 15; }
    const int cb = 64 * w + q;
    {
        const float* wup = inp(17) + (size_t)j * 2 * 32 * 512;
        const float* aup = inp(19) + (size_t)j * 32 * 512;
        __syncthreads();
#pragma unroll 8
        for (int k = 0; k < 32; ++k) { sWT[tid * WS + k] = (bf16_t)f2bf(wup[k * 512 + tid]); sWT[tid * WS + 32 + k] = (bf16_t)f2bf(wup[(32 + k) * 512 + tid]); sWT[tid * WS + 64 + k] = (bf16_t)f2bf(aup[k * 512 + tid]); }
        __syncthreads();
        float w0f[4], w0b[4], a0c[4], kkc[4], kac[4], mr0[4], mr1[4], mk0[4], mk1[4], mv0[4], mv1[4];
#pragma unroll
        for (int ct = 0; ct < 4; ++ct) { const int c = cb + 16 * ct;
            w0f[ct] = inp(16)[(size_t)j * 1024 + c]; w0b[ct] = inp(16)[(size_t)j * 1024 + 512 + c]; a0c[ct] = inp(18)[(size_t)j * 512 + c]; kkc[ct] = inp(21)[j * 512 + c]; kac[ct] = inp(22)[j * 512 + c];
            mr0[ct] = mu[c]; mr1[ct] = mu[1728 + c]; mk0[ct] = mu[512 + c]; mk1[ct] = mu[1728 + 512 + c]; mv0[ct] = mu[1024 + c]; mv1[ct] = mu[1728 + 1024 + c]; }
        float ml0[3], ml1[3];
#pragma unroll
        for (int u = 0; u < 3; ++u) { ml0[u] = mu[1536 + lj[u]]; ml1[u] = mu[1728 + 1536 + lj[u]]; }
        for (int chunk = b0_; chunk < 256; chunk += gd_) {
            const int r0 = chunk * 144, t0 = (chunk & 15) * 144;
            bf16_t lw[3][3];
            auto load_group = [&](int gi) {
#pragma unroll
                for (int u = 0; u < 3; ++u) { const bf16_t* zl = Z + ((size_t)(r0 + 16 * gi + ltk[u]) * EV_INP + 1568 + 1536 + lj[u]) - EV_INP;
                    lw[u][0] = zl[0]; lw[u][1] = zl[EV_INP]; lw[u][2] = zl[2 * EV_INP]; }
            };
            load_group(0);
#pragma unroll 1
            for (int gi = 0; gi < 9; ++gi) {
                bf16_t* lr = sLR + (gi & 1) * 16 * WS;
#pragma unroll
                for (int u = 0; u < 3; ++u) { const int t = t0 + 16 * gi + ltk[u];
                    const bool hp = (t != 0) && (t != CL), hn = (t != CL - 1) && (t != TT - 1);
                    const float sl = shift3(bf1(lw[u][1]), hp ? bf1(lw[u][0]) : 0.f, hn ? bf1(lw[u][2]) : 0.f, ml0[u], ml1[u]);
                    lr[ltk[u] * WS + lj[u]] = (bf16_t)f2bf((lj[u] < 64) ? (2.0f * sigmoidf_(2.0f * sl) - 1.0f) : sl); }
                bf16_t zr_[4][6], zk_[4][6], zv_[4][6];
                { const bf16_t* zb = Z + ((size_t)(r0 + 16 * gi + 4 * g) * EV_INP + 1568 + cb) - EV_INP;
#pragma unroll
                  for (int i = 0; i < 6; ++i)
#pragma unroll
                      for (int ct = 0; ct < 4; ++ct) { const bf16_t* zz = zb + (size_t)i * EV_INP + 16 * ct; zr_[ct][i] = zz[0]; zk_[ct][i] = zz[512]; zv_[ct][i] = zz[1024]; } }
                if (gi + 1 < 9) load_group(gi + 1);
                __syncthreads();
                f32x4 Cf[4], Cb[4], Ca[4];
                { const bf16x8 A0 = *(const bf16x8*)(lr + q * WS + 8 * g), A1 = *(const bf16x8*)(lr + q * WS + 32 + 8 * g), A2 = *(const bf16x8*)(lr + q * WS + 64 + 8 * g);
                  const f32x4 z4 = {0.f, 0.f, 0.f, 0.f};
                  const LAS bf16_t* wq = (const LAS bf16_t*)sWT + (64 * w + q) * WS + 8 * g; asm volatile("" : "+v"(wq));
#pragma unroll
                  for (int ct = 0; ct < 4; ++ct) { const LAS bf16_t* wc = wq + 16 * ct * WS;
                      Cf[ct] = __builtin_amdgcn_mfma_f32_16x16x32_bf16(A0, *(const LAS bf16x8*)(wc), z4, 0, 0, 0); Cb[ct] = __builtin_amdgcn_mfma_f32_16x16x32_bf16(A1, *(const LAS bf16x8*)(wc + 32), z4, 0, 0, 0);
                      Ca[ct] = __builtin_amdgcn_mfma_f32_16x16x32_bf16(A2, *(const LAS bf16x8*)(wc + 64), z4, 0, 0, 0); } }
#pragma unroll
                for (int r = 0; r < 4; ++r) { const int t = t0 + 16 * gi + 4 * g + r;
                    const bool hp = (t != 0) && (t != CL), hn = (t != CL - 1) && (t != TT - 1);
                    float rs[4], ks[4], vs[4], kk[4], a[4], ss = 0.f;
#pragma unroll
                    for (int ct = 0; ct < 4; ++ct) {
                        rs[ct] = shift3(bf1(zr_[ct][r + 1]), hp ? bf1(zr_[ct][r]) : 0.f, hn ? bf1(zr_[ct][r + 2]) : 0.f, mr0[ct], mr1[ct]);
                        ks[ct] = shift3(bf1(zk_[ct][r + 1]), hp ? bf1(zk_[ct][r]) : 0.f, hn ? bf1(zk_[ct][r + 2]) : 0.f, mk0[ct], mk1[ct]);
                        vs[ct] = shift3(bf1(zv_[ct][r + 1]), hp ? bf1(zv_[ct][r]) : 0.f, hn ? bf1(zv_[ct][r + 2]) : 0.f, mv0[ct], mv1[ct]);
                        kk[ct] = ks[ct] * kkc[ct]; ss += kk[ct] * kk[ct]; a[ct] = sigmoidf_(Ca[ct][r] + a0c[ct]); }
                    const float rn = __builtin_amdgcn_rsqf(fmaxf(red16(ss), 1e-24f));
                    bf16_t* fo = F + (size_t)(r0 + 16 * gi + 4 * g + r) * 4096 + cb;
#pragma unroll
                    for (int ct = 0; ct < 4; ++ct) { const float kkn = kk[ct] * rn; bf16_t* f1 = fo + 16 * ct;
                        f1[0] = (bf16_t)f2bf(rs[ct]); f1[512] = (bf16_t)f2bf(ks[ct] * (1.0f + (a[ct] - 1.0f) * kac[ct])); f1[1024] = (bf16_t)f2bf(vs[ct]); f1[1536] = (bf16_t)f2bf(-kkn); f1[2048] = (bf16_t)f2bf(kkn * a[ct]);
                        f1[2560] = (bf16_t)f2bf(0.6065306597126334f * sigmoidf_(Cf[ct][r] + w0f[ct]));
                        f1[3072] = (bf16_t)f2bf(0.6065306597126334f * sigmoidf_(Cb[ct][r] + w0b[ct])); }
                }
            }
            __syncthreads();
        }
    }
    {
        const float* gup = inp(20) + (size_t)j * 96 * 512;
        __syncthreads();
#pragma unroll 8
        for (int k = 0; k < 96; ++k) sWT[tid * WS + k] = (bf16_t)f2bf(gup[k * 512 + tid]);
        __syncthreads();
        float ml0[3], ml1[3];
#pragma unroll
        for (int u = 0; u < 3; ++u) { ml0[u] = mu[1632 + lj[u]]; ml1[u] = mu[1728 + 1632 + lj[u]]; }
        for (int chunk = b0_; chunk < 256; chunk += gd_) {
            const int r0 = chunk * 144, t0 = (chunk & 15) * 144;
            bf16_t lw[3][3];
            auto load_group = [&](int gi) {
#pragma unroll
                for (int u = 0; u < 3; ++u) { const bf16_t* zl = Z + ((size_t)(r0 + 16 * gi + ltk[u]) * EV_INP + 1568 + 1632 + lj[u]) - EV_INP;
                    lw[u][0] = zl[0]; lw[u][1] = zl[EV_INP]; lw[u][2] = zl[2 * EV_INP]; }
            };
            load_group(0);
#pragma unroll 1
            for (int gi = 0; gi < 9; ++gi) {
                bf16_t* lr = sLR + (gi & 1) * 16 * WS;
#pragma unroll
                for (int u = 0; u < 3; ++u) { const int t = t0 + 16 * gi + ltk[u];
                    const bool hp = (t != 0) && (t != CL), hn = (t != CL - 1) && (t != TT - 1);
                    lr[ltk[u] * WS + lj[u]] = (bf16_t)f2bf(sigmoidf_(shift3(bf1(lw[u][1]), hp ? bf1(lw[u][0]) : 0.f, hn ? bf1(lw[u][2]) : 0.f, ml0[u], ml1[u]))); }
                if (gi + 1 < 9) load_group(gi + 1);
                __syncthreads();
                const bf16x8 A0 = *(const bf16x8*)(lr + q * WS + 8 * g), A1 = *(const bf16x8*)(lr + q * WS + 32 + 8 * g), A2 = *(const bf16x8*)(lr + q * WS + 64 + 8 * g);
                const LAS bf16_t* wq = (const LAS bf16_t*)sWT + (64 * w + q) * WS + 8 * g; asm volatile("" : "+v"(wq));
#pragma unroll
                for (int ct = 0; ct < 4; ++ct) { f32x4 c4 = {0.f, 0.f, 0.f, 0.f}; const LAS bf16_t* wc = wq + 16 * ct * WS;
                    c4 = __builtin_amdgcn_mfma_f32_16x16x32_bf16(A0, *(const LAS bf16x8*)(wc), c4, 0, 0, 0); c4 = __builtin_amdgcn_mfma_f32_16x16x32_bf16(A1, *(const LAS bf16x8*)(wc + 32), c4, 0, 0, 0); c4 = __builtin_amdgcn_mfma_f32_16x16x32_bf16(A2, *(const LAS bf16x8*)(wc + 64), c4, 0, 0, 0);
#pragma unroll
                    for (int r = 0; r < 4; ++r) F[(size_t)(r0 + 16 * gi + 4 * g + r) * 4096 + 3584 + cb + 16 * ct] = (bf16_t)f2bf(c4[r]); }
            }
            __syncthreads();
        }
    }
}

__device__ __forceinline__ int scan_tok(int s, int dir) { return dir == 0 ? s : (s < CL ? (CL - 1 - s) : (TT + CL - 1 - s)); }
__device__ __forceinline__ void rwkv_scan_phase(const bf16_t* F, bf16_t* O, float* sm) {
    const int tid = tid_(), rp = (tid >> 3) & 31, kg = tid & 7; const int b0_ = bid_(), gd_ = gdim_();
    float* sF = sm;
    float* sO = sm + 2 * 6 * 32 * 64;
    for (int item = b0_; item < 256; item += gd_) {
        const int bl = item >> 4, h = (item >> 1) & 7, dir = item & 1;
        const size_t rb = (size_t)bl * TT;
        f32x4 S[4] = {{0.f, 0.f, 0.f, 0.f}, {0.f, 0.f, 0.f, 0.f}, {0.f, 0.f, 0.f, 0.f}, {0.f, 0.f, 0.f, 0.f}};
        u32x4 pre[3];
        auto load_tile = [&](int tile) {
#pragma unroll
            for (int i = 0; i < 3; ++i) { const int q = tid + 512 * i, pair = q >> 3, part = q & 7, tokl = pair / 6, feat = pair - tokl * 6;
                const int tk = scan_tok(tile * 32 + tokl, dir);
                const int fo = (feat < 5) ? feat * 512 : (2560 + 512 * dir);
                pre[i] = *(const u32x4*)(F + (rb + tk) * 4096 + fo + h * 64 + part * 8); }
        };
        auto store_tile = [&](int buf) {
#pragma unroll
            for (int i = 0; i < 3; ++i) { const int q = tid + 512 * i, pair = q >> 3, part = q & 7, tokl = pair / 6, feat = pair - tokl * 6;
                float v[8]; unpack8(pre[i], v);
                if (feat == 5) {
#pragma unroll
                    for (int jx = 0; jx < 8; ++jx) v[jx] = __expf(-v[jx]); }
                float* d = sF + (((buf * 6 + feat) * 32 + tokl) * 64 + part * 8);
                *(f32x4*)d = (f32x4){v[0], v[1], v[2], v[3]}; *(f32x4*)(d + 4) = (f32x4){v[4], v[5], v[6], v[7]}; }
        };
        __syncthreads();
        load_tile(0); store_tile(0);
        __syncthreads();
        for (int tile = 0; tile < 72; ++tile) {
            const int buf = tile & 1;
            if (tile + 1 < 72) load_tile(tile + 1);
            const float* fb = sF + buf * 6 * 32 * 64;
            float* ob = sO + buf * 32 * 64;
#define RW_LOAD(P, off) { const float* fr_ = pa_ + (off); _Pragma("unroll") for (int e = 0; e < 2; ++e) { P##r[e] = *(const f32x4*)(fr_ + 4 * e); P##k[e] = *(const f32x4*)(fr_ + 2048 + 4 * e); \
                P##a[e] = *(const f32x4*)(fr_ + 3 * 2048 + 4 * e); P##b[e] = *(const f32x4*)(fr_ + 4 * 2048 + 4 * e); P##w[e] = *(const f32x4*)(fr_ + 5 * 2048 + 4 * e); } \
                P##v0 = pv_[(off)]; P##v1 = pv_[(off) + 1]; }
#define RW_STEP(P, off) { f32x4 ac0 = S[0] * P##a[0]; ac0 += S[1] * P##a[1]; f32x4 ac1 = S[2] * P##a[0]; ac1 += S[3] * P##a[1]; \
                const f32x2 pa0_ = __builtin_shufflevector(ac0, ac0, 0, 1) + __builtin_shufflevector(ac0, ac0, 2, 3), pa1_ = __builtin_shufflevector(ac1, ac1, 0, 1) + __builtin_shufflevector(ac1, ac1, 2, 3); \
                float sa0 = pa0_[0] + pa0_[1], sa1 = pa1_[0] + pa1_[1]; sa0 = red8(sa0); sa1 = red8(sa1); \
                S[0] = S[0] * P##w[0] + (sa0 * P##b[0] + P##v0 * P##k[0]); S[1] = S[1] * P##w[1] + (sa0 * P##b[1] + P##v0 * P##k[1]); \
                S[2] = S[2] * P##w[0] + (sa1 * P##b[0] + P##v1 * P##k[0]); S[3] = S[3] * P##w[1] + (sa1 * P##b[1] + P##v1 * P##k[1]); \
                f32x4 oc0 = S[0] * P##r[0]; oc0 += S[1] * P##r[1]; f32x4 oc1 = S[2] * P##r[0]; oc1 += S[3] * P##r[1]; \
                const f32x2 po0_ = __builtin_shufflevector(oc0, oc0, 0, 1) + __builtin_shufflevector(oc0, oc0, 2, 3), po1_ = __builtin_shufflevector(oc1, oc1, 0, 1) + __builtin_shufflevector(oc1, oc1, 2, 3); \
                float o0 = po0_[0] + po0_[1], o1 = po1_[0] + po1_[1]; { const float x0_ = o0 + dppf<0x141>(o0), x1_ = o1 + dppf<0x141>(o1); float x_ = hi4 ? x1_ : x0_; x_ += dppf<0xB1>(x_); x_ += dppf<0x4E>(x_); po_[(off)] = x_; } }
            const bool hi4 = (kg & 4) != 0;
            if (tid < 256) { f32x4 Ar[2], Ak[2], Aa[2], Ab[2], Aw[2], Br[2], Bk[2], Ba[2], Bb[2], Bw[2]; float Av0, Av1, Bv0, Bv1;
              const float* pa_ = fb + kg * 8; const float* pv_ = fb + 2 * 2048 + 2 * rp; float* po_ = ob + 2 * rp + (kg >> 2);
              RW_LOAD(A, 0)
#pragma unroll 1
              for (int i = 0; i < 32; i += 2) {
                  RW_LOAD(B, 64)
                  RW_STEP(A, 0)
                  RW_LOAD(A, 128)
                  RW_STEP(B, 64)
                  pa_ += 128; pv_ += 128; po_ += 128;
              } }
#undef RW_LOAD
#undef RW_STEP
            if (tile + 1 < 72) store_tile(buf ^ 1);
            __syncthreads();
            { const int tokl = tid >> 4, c4 = (tid & 15) * 4; const int tk = scan_tok(tile * 32 + tokl, dir);
              const f32x4 v = *(const f32x4*)(ob + tokl * 64 + c4);
              u32x2 w; w.x = pk2(v[0], v[1]); w.y = pk2(v[2], v[3]);
              *(u32x2*)(O + (rb + tk) * 2048 + 1024 + 512 * dir + h * 64 + c4) = w; }
        }
        __syncthreads();
    }
}

__device__ __forceinline__ void gla_phase(const Params& p, int j, const bf16_t* Z, bf16_t* O, float* sm) {
    constexpr int LS = 68, BS = 72;
    bf16_t* sQb = (bf16_t*)sm; bf16_t* sKb = sQb + 64 * BS; bf16_t* sKdT = sKb + 64 * BS; bf16_t* sVT = sKdT + 64 * BS; bf16_t* sAtt = sVT + 64 * BS; bf16_t* sST = sAtt + 64 * BS;
    float* sB = (float*)(sST + 64 * BS);
    float* sAup = sB + 64 * LS; float* sAd = sAup + 16 * 64; float* sSeg = sAd + 64 * 16; float* sTot = sSeg + 8 * 64;
    const int tid = tid_(), lane = tid & 63, wid = tid >> 6, q = lane & 15, g = lane >> 4; const int b0_ = bid_(), gd_ = gdim_();
    const int ti = wid >> 1, tc0 = (wid & 1) * 2;
    const int tok = tid >> 3, d0 = (tid & 7) * 8;
    for (int item = b0_; item < 256; item += gd_) {
        const int bl = item >> 4, h = (item >> 2) & 3, dir = (item >> 1) & 1, vh = item & 1;
        const size_t rb = (size_t)bl * TT;
        const float* aup = inp(12) + ((size_t)(j * 2 + dir) * 16) * 256 + h * 64;
        const float* abias = inp(13) + (size_t)(j * 2 + dir) * 256 + h * 64;
        __syncthreads();
        for (int idx = tid; idx < 64 * BS; idx += 512) sST[idx] = 0;
        float aupc[16]; const float biasc = abias[tid & 63];
#pragma unroll
        for (int i = 0; i < 16; ++i) aupc[i] = aup[i * 256 + (tid & 63)];
        f32x4 STa[2] = {{0.f, 0.f, 0.f, 0.f}, {0.f, 0.f, 0.f, 0.f}};
        u32x4 rq, rk, rv, ra;
        auto load_raw = [&](int ci) {
            const bf16_t* zr = Z + (rb + scan_tok(ci * 64 + tok, dir)) * EV_INP;
            rq = *(const u32x4*)(zr + h * 64 + d0); rk = *(const u32x4*)(zr + 256 + h * 64 + d0); rv = *(const u32x4*)(zr + 512 + h * 128 + vh * 64 + d0);
            const int t2 = (tid < 128) ? (tid >> 1) : 0;
            ra = *(const u32x4*)(Z + (rb + scan_tok(ci * 64 + t2, dir)) * EV_INP + 1536 + dir * 16 + (tid & 1) * 8);
        };
        load_raw(0);
        __syncthreads();
        for (int ci = 0; ci < 36; ++ci) {
            float q8[8], k8[8], v8[8];
            unpack8(rq, q8); unpack8(rk, k8); unpack8(rv, v8);
            if (tid < 128) { float a8[8]; unpack8(ra, a8);
                *(f32x4*)(sAd + (tid >> 1) * 16 + (tid & 1) * 8) = (f32x4){a8[0], a8[1], a8[2], a8[3]}; *(f32x4*)(sAd + (tid >> 1) * 16 + (tid & 1) * 8 + 4) = (f32x4){a8[4], a8[5], a8[6], a8[7]}; }
            __syncthreads();
            float loc[8];
            { const int dd = tid & 63, seg = tid >> 6; float run = 0.f;
#pragma unroll
              for (int i = 0; i < 8; ++i) { const float* ar = sAd + (seg * 8 + i) * 16;
                  const f32x4 a0 = *(const f32x4*)ar, a1 = *(const f32x4*)(ar + 4), a2 = *(const f32x4*)(ar + 8), a3 = *(const f32x4*)(ar + 12);
                  float x = biasc;
#pragma unroll
                  for (int e = 0; e < 4; ++e) { x += a0[e] * aupc[e]; x += a1[e] * aupc[4 + e]; x += a2[e] * aupc[8 + e]; x += a3[e] * aupc[12 + e]; }
                  run += (fminf(x, 0.f) - __logf(1.0f + __expf(-fabsf(x)))) * (1.0f / 16.0f); loc[i] = run; }
              sSeg[seg * 64 + dd] = run; }
            __syncthreads();
            { const int dd = tid & 63, seg = tid >> 6; float pre = 0.f;
              for (int s2 = 0; s2 < seg; ++s2) pre += sSeg[s2 * 64 + dd];
#pragma unroll
              for (int i = 0; i < 8; ++i) sB[(seg * 8 + i) * LS + dd] = loc[i] + pre; }
            __syncthreads();
            { float qb[8], kb[8];
#pragma unroll
              for (int i = 0; i < 8; ++i) { const float bb = sB[tok * LS + d0 + i], tot = sB[63 * LS + d0 + i];
                  qb[i] = q8[i] * 0.125f * __expf(bb); kb[i] = k8[i] * __expf(-bb);
                  sKdT[(d0 + i) * BS + tok] = (bf16_t)f2bf(k8[i] * __expf(tot - bb));
                  sVT[(d0 + i) * BS + tok] = (bf16_t)f2bf(v8[i]);
                  if (tok == 63) sTot[d0 + i] = tot; }
              *(u32x4*)(sQb + tok * BS + d0) = pack8(qb); *(u32x4*)(sKb + tok * BS + d0) = pack8(kb); }
            if (ci + 1 < 36) load_raw(ci + 1);
            __syncthreads();
            f32x4 oacc[2];
            { bf16x8 Aq[2];
#pragma unroll
              for (int ks = 0; ks < 2; ++ks) Aq[ks] = *(const bf16x8*)(sQb + (16 * ti + q) * BS + 32 * ks + 8 * g);
#pragma unroll
              for (int c = 0; c < 2; ++c) { const int tj = tc0 + c;
                  f32x4 at = {0.f, 0.f, 0.f, 0.f};
                  if (tj <= ti) {
#pragma unroll
                      for (int ks = 0; ks < 2; ++ks) { const bf16x8 Bk = *(const bf16x8*)(sKb + (16 * tj + q) * BS + 32 * ks + 8 * g); at = __builtin_amdgcn_mfma_f32_16x16x32_bf16(Aq[ks], Bk, at, 0, 0, 0); }
                      if (tj == ti) {
#pragma unroll
                          for (int r = 0; r < 4; ++r) if (q > 4 * g + r) at[r] = 0.f; } }
#pragma unroll
                  for (int r = 0; r < 4; ++r) sAtt[(16 * ti + 4 * g + r) * BS + 16 * tj + q] = (bf16_t)f2bf(at[r]);
                  f32x4 oc = {0.f, 0.f, 0.f, 0.f};
#pragma unroll
                  for (int ks = 0; ks < 2; ++ks) { const bf16x8 Bs = *(const bf16x8*)(sST + (16 * tj + q) * BS + 32 * ks + 8 * g); oc = __builtin_amdgcn_mfma_f32_16x16x32_bf16(Aq[ks], Bs, oc, 0, 0, 0); }
                  oacc[c] = oc; } }
            __syncthreads();
            { bf16x8 Aa[2], Av[2];
#pragma unroll
              for (int ks = 0; ks < 2; ++ks) { Aa[ks] = *(const bf16x8*)(sAtt + (16 * ti + q) * BS + 32 * ks + 8 * g); Av[ks] = *(const bf16x8*)(sVT + (16 * ti + q) * BS + 32 * ks + 8 * g); }
#pragma unroll
              for (int c = 0; c < 2; ++c) { const int tv = tc0 + c;
                  f32x4 oc = oacc[c];
#pragma unroll
                  for (int ks = 0; ks < 2; ++ks) { const bf16x8 Bv = *(const bf16x8*)(sVT + (16 * tv + q) * BS + 32 * ks + 8 * g); oc = __builtin_amdgcn_mfma_f32_16x16x32_bf16(Aa[ks], Bv, oc, 0, 0, 0); }
#pragma unroll
                  for (int r = 0; r < 4; ++r) { const int tk = scan_tok(ci * 64 + 16 * ti + 4 * g + r, dir);
                      O[(rb + tk) * 2048 + 512 * dir + h * 128 + vh * 64 + 16 * tv + q] = (bf16_t)f2bf(oc[r]); }
                  const float et = __expf(sTot[16 * tv + q]);
                  f32x4 st = STa[c] * et;
#pragma unroll
                  for (int ks = 0; ks < 2; ++ks) { const bf16x8 Bkd = *(const bf16x8*)(sKdT + (16 * tv + q) * BS + 32 * ks + 8 * g); st = __builtin_amdgcn_mfma_f32_16x16x32_bf16(Av[ks], Bkd, st, 0, 0, 0); }
                  STa[c] = st;
#pragma unroll
                  for (int r = 0; r < 4; ++r) sST[(16 * ti + 4 * g + r) * BS + 16 * tv + q] = (bf16_t)f2bf(st[r]); } }
            __syncthreads();
        }
    }
}

__device__ __forceinline__ void even_merge_phase(const Params& p, int j, const bf16_t* Z, const bf16_t* F, const bf16_t* O, bf16_t* Y) {
    const int tid = tid_(), lane = tid & 63, gw = bid_() * 8 + (tid >> 6), nw = gdim_() * 8;
    const int c8 = lane * 8;
    const float* pgg = inp(14); const float* plg = inp(24); const float* plb = inp(25); const float* prk = inp(23);
    float gg[8], lg[8], lb[8], rk[8];
#pragma unroll
    for (int i = 0; i < 8; ++i) { gg[i] = pgg[j * 128 + ((c8 + i) & 127)]; lg[i] = plg[j * 512 + c8 + i]; lb[i] = plb[j * 512 + c8 + i]; rk[i] = prk[j * 512 + c8 + i]; }
    for (int zl0 = gw * 2; zl0 < HROWS; zl0 += nw * 2) {
        u32x4 L[2][9];
#pragma unroll
        for (int tt = 0; tt < 2; ++tt) { const int zl = zl0 + tt;
            const bf16_t* orow = O + (size_t)zl * 2048; const bf16_t* zrow = Z + (size_t)zl * EV_INP; const bf16_t* frow = F + (size_t)zl * 4096;
            L[tt][0] = *(const u32x4*)(orow + c8); L[tt][1] = *(const u32x4*)(orow + 512 + c8); L[tt][2] = *(const u32x4*)(zrow + 1024 + c8);
            L[tt][3] = *(const u32x4*)(orow + 1024 + c8); L[tt][4] = *(const u32x4*)(orow + 1536 + c8);
            L[tt][5] = *(const u32x4*)(frow + c8); L[tt][6] = *(const u32x4*)(frow + 512 + c8); L[tt][7] = *(const u32x4*)(frow + 1024 + c8); L[tt][8] = *(const u32x4*)(frow + 3584 + c8); }
#pragma unroll
        for (int tt = 0; tt < 2; ++tt) { const int zl = zl0 + tt;
            float a[8], b[8], y[8];
            unpack8(L[tt][0], a); unpack8(L[tt][1], b);
            float ss = 0.f;
#pragma unroll
            for (int i = 0; i < 8; ++i) { a[i] += b[i]; ss += a[i] * a[i]; }
            ss = red16(ss);
            const float rs = rsqrtf(ss * (1.0f / 128.0f) + 1e-6f);
            unpack8(L[tt][2], b);
#pragma unroll
            for (int i = 0; i < 8; ++i) y[i] = a[i] * rs * gg[i] * siluf_(b[i]);
            *(u32x4*)(Y + (size_t)zl * D + c8) = pack8(y);
            unpack8(L[tt][3], a); unpack8(L[tt][4], b);
            float sm_ = 0.f;
#pragma unroll
            for (int i = 0; i < 8; ++i) { a[i] += b[i]; sm_ += a[i]; }
            const float mean = red8(sm_) * (1.0f / 64.0f);
            float sv = 0.f;
#pragma unroll
            for (int i = 0; i < 8; ++i) { a[i] -= mean; sv += a[i] * a[i]; }
            const float rstd = rsqrtf(red8(sv) * (1.0f / 64.0f) + 64e-5f);
            float r8[8], k8[8], v8[8], g8[8];
            unpack8(L[tt][5], r8); unpack8(L[tt][6], k8); unpack8(L[tt][7], v8); unpack8(L[tt][8], g8);
            float bs = 0.f;
#pragma unroll
            for (int i = 0; i < 8; ++i) bs += r8[i] * k8[i] * rk[i];
            bs = red8(bs);
#pragma unroll
            for (int i = 0; i < 8; ++i) y[i] = (a[i] * rstd * lg[i] + lb[i] + bs * v8[i]) * g8[i];
            *(u32x4*)(Y + (size_t)zl * D + 512 + c8) = pack8(y);
        }
    }
}

__device__ __forceinline__ void odd_feat_phase(const Params& p, int j, bf16_t* Z, bf16_t* VTG, bf16_t* VTN, float* sm) {
    const int tid = tid_(), lane = tid & 63, wid = tid >> 6; const int b0_ = bid_(), gd_ = gdim_();
    bf16_t* sVT = (bf16_t*)sm;
    const int c8 = lane * 8, d0 = (lane & 7) * 8;
    const float* pqg = inp(28); const float* pkg = inp(29);
    float qg[8], kg_[8], inv[8];
#pragma unroll
    for (int i = 0; i < 8; ++i) { qg[i] = pqg[j * 64 + d0 + i]; kg_[i] = pkg[j * 64 + d0 + i]; inv[i] = exp2f(-(float)((d0 & 15) + i) * (13.287712379549449f / 16.0f)); }
    const int ax = d0 >> 5, pp = (d0 >> 4) & 1;
    for (int tile = b0_; tile < MROWS / 64; tile += gd_) {
        const int row0 = tile * 64; const int b = row0 / TT, t0 = row0 - b * TT;
        const bool lat = t0 >= CL;
        for (int i8 = 0; i8 < 8; ++i8) {
            const int tokl = wid * 8 + i8; const int t = t0 + tokl;
            bf16_t* zr = Z + (size_t)(row0 + tokl) * OD_IN;
            const u32x4 wq = *(const u32x4*)(zr + c8), wk = *(const u32x4*)(zr + 512 + (c8 & 127)), wvc = *(const u32x4*)(zr + 640 + (c8 & 127)), wqd = *(const u32x4*)(zr + 768 + c8), wvd = *(const u32x4*)(zr + 1792 + c8);
            const int tl = t - CL;
            const float pos = (float)(ax == 0 ? (tl >> 6) : (tl & 63));
            float cs[8], sn[8];
            if (lat) {
#pragma unroll
                for (int i = 0; i < 8; ++i) { const float ang = pos * inv[i]; cs[i] = __cosf(ang); sn[i] = __sinf(ang); } }
            float x[8], xp[8];
            unpack8(wq, x);
            { float ss = 0.f;
#pragma unroll
              for (int i = 0; i < 8; ++i) ss += x[i] * x[i];
              const float rs = rsqrtf(red8(ss) * (1.0f / 64.0f) + 1e-6f);
#pragma unroll
              for (int i = 0; i < 8; ++i) x[i] = x[i] * rs * qg[i]; }
            if (lat) {
#pragma unroll
                for (int i = 0; i < 8; ++i) { xp[i] = shx2(x[i]); }
#pragma unroll
                for (int i = 0; i < 8; ++i) x[i] = (pp == 0) ? (x[i] * cs[i] - xp[i] * sn[i]) : (xp[i] * sn[i] + x[i] * cs[i]); }
#pragma unroll
            for (int i = 0; i < 8; ++i) x[i] *= 0.18033688011112042f;
            *(u32x4*)(zr + c8) = pack8(x);
            float kx[8];
            unpack8(wk, kx);
            { float ss = 0.f;
#pragma unroll
              for (int i = 0; i < 8; ++i) ss += kx[i] * kx[i];
              const float rs = rsqrtf(red8(ss) * (1.0f / 64.0f) + 1e-6f);
#pragma unroll
              for (int i = 0; i < 8; ++i) kx[i] = kx[i] * rs * kg_[i]; }
            if (lat) {
#pragma unroll
                for (int i = 0; i < 8; ++i) { xp[i] = shx2(kx[i]); }
#pragma unroll
                for (int i = 0; i < 8; ++i) kx[i] = (pp == 0) ? (kx[i] * cs[i] - xp[i] * sn[i]) : (xp[i] * sn[i] + kx[i] * cs[i]); }
            if (lane < 16) {
                *(u32x4*)(zr + 512 + c8) = pack8(kx);
                bf16_t* vt = sVT + (size_t)c8 * 72 + tokl;
                vt[0] = (bf16_t)(wvc.x & 0xffff); vt[72] = (bf16_t)(wvc.x >> 16); vt[2 * 72] = (bf16_t)(wvc.y & 0xffff); vt[3 * 72] = (bf16_t)(wvc.y >> 16);
                vt[4 * 72] = (bf16_t)(wvc.z & 0xffff); vt[5 * 72] = (bf16_t)(wvc.z >> 16); vt[6 * 72] = (bf16_t)(wvc.w & 0xffff); vt[7 * 72] = (bf16_t)(wvc.w >> 16);
            }
            unpack8(wqd, x);
#pragma unroll
            for (int i = 0; i < 8; ++i) x[i] *= 0.18033688011112042f;
            *(u32x4*)(zr + 768 + c8) = pack8(x);
            { bf16_t* vt = sVT + (size_t)(128 + c8) * 72 + tokl;
              vt[0] = (bf16_t)(wvd.x & 0xffff); vt[72] = (bf16_t)(wvd.x >> 16); vt[2 * 72] = (bf16_t)(wvd.y & 0xffff); vt[3 * 72] = (bf16_t)(wvd.y >> 16);
              vt[4 * 72] = (bf16_t)(wvd.z & 0xffff); vt[5 * 72] = (bf16_t)(wvd.z >> 16); vt[6 * 72] = (bf16_t)(wvd.w & 0xffff); vt[7 * 72] = (bf16_t)(wvd.w >> 16); }
        }
        __syncthreads();
#pragma unroll
        for (int i = 0; i < 10; ++i) { const int id = tid + 512 * i, row = id >> 3, part = id & 7;
            const u32x4 w = *(const u32x4*)(sVT + row * 72 + part * 8);
            bf16_t* dst = (row < 128) ? VTG + ((size_t)(b * 2) * 64 + row) * TT : VTN + ((size_t)(b * 8) * 64 + (row - 128)) * TT;
            *(u32x4*)(dst + t0 + part * 8) = w; }
        __syncthreads();
    }
}

struct AttnTask { const bf16_t* Q; const bf16_t* Kd; const bf16_t* VTd; int nd; const bf16_t* Kn; const bf16_t* VTn; int nb; int r; int qc0; const float* rpb; bf16_t* Y; };
__device__ __forceinline__ void attn_load(const bf16_t* Kp, const bf16_t* VTp, bf16x8 (&Kf)[2][2], bf16x8 (&Vf)[4], int q, int g) {
#pragma unroll
    for (int kt = 0; kt < 2; ++kt)
#pragma unroll
        for (int ks = 0; ks < 2; ++ks) Kf[kt][ks] = *(const bf16x8*)(Kp + (size_t)(16 * kt + q) * OD_IN + 32 * ks + 8 * g);
#pragma unroll
    for (int dt = 0; dt < 4; ++dt) { const bf16_t* vp = VTp + (size_t)(16 * dt + q) * TT + 4 * g;
        const u32x2 lo = *(const u32x2*)vp, hi = *(const u32x2*)(vp + 16);
        u32x4 w; w.x = lo.x; w.y = lo.y; w.z = hi.x; w.w = hi.y; Vf[dt] = __builtin_bit_cast(bf16x8, w); }
}
__device__ __forceinline__ void attn_compute(const bf16x8 (&Kf)[2][2], const bf16x8 (&Vf)[4], const bf16x8 (&Qf)[2][2], f32x4 (&Oa)[2][4], float (&mrun)[2], float (&lrun)[2], int q, int g, bool nbr, int qc0, int cb, const float* brow, int a32) {
#pragma unroll
    for (int qt = 0; qt < 2; ++qt) {
        if (nbr && ((qc0 + 16 * qt == 0 && cb == 32) || (qc0 + 16 * qt == 48 && cb == 0))) continue;
        f32x4 S0 = {0.f, 0.f, 0.f, 0.f}, S1 = {0.f, 0.f, 0.f, 0.f};
#pragma unroll
        for (int ks = 0; ks < 2; ++ks) { S0 = __builtin_amdgcn_mfma_f32_16x16x32_bf16(Kf[0][ks], Qf[qt][ks], S0, 0, 0, 0); S1 = __builtin_amdgcn_mfma_f32_16x16x32_bf16(Kf[1][ks], Qf[qt][ks], S1, 0, 0, 0); }
        if (nbr) {
            const int c = qc0 + 16 * qt + q; int st = c - 8; st = st < 0 ? 0 : (st > 48 ? 48 : st);
#pragma unroll
            for (int i = 0; i < 4; ++i) { const int cw0 = cb + 4 * g + i, cw1 = cw0 + 16;
                S0[i] = (cw0 >= st && cw0 < st + 16) ? S0[i] + brow[cw0 - c + 15] : -200.f;
                S1[i] = (cw1 >= st && cw1 < st + 16) ? S1[i] + brow[cw1 - c + 15] : -200.f; }
        }
        float pv[8]; float ps = 0.f;
#pragma unroll
        for (int i = 0; i < 4; ++i) { pv[i] = __builtin_amdgcn_exp2f(fminf(S0[i], 80.f)); pv[4 + i] = __builtin_amdgcn_exp2f(fminf(S1[i], 80.f)); ps += pv[i] + pv[4 + i]; }
        lrun[qt] += ps;
        const bf16x8 Pq = __builtin_bit_cast(bf16x8, pack8(pv));
        __builtin_amdgcn_s_setprio(1);
#pragma unroll
        for (int dt = 0; dt < 4; ++dt) Oa[qt][dt] = __builtin_amdgcn_mfma_f32_16x16x32_bf16(Vf[dt], Pq, Oa[qt][dt], 0, 0, 0);
        __builtin_amdgcn_s_setprio(0);
    }
}
__device__ __forceinline__ void attn_wave(const AttnTask& t, int lane, int a32) {
    const int q = lane & 15, g = lane >> 4;
    bf16x8 Qf[2][2];
#pragma unroll
    for (int qt = 0; qt < 2; ++qt)
#pragma unroll
        for (int ks = 0; ks < 2; ++ks) Qf[qt][ks] = *(const bf16x8*)(t.Q + (size_t)(16 * qt + q) * OD_IN + 32 * ks + 8 * g);
    f32x4 Oa[2][4];
#pragma unroll
    for (int qt = 0; qt < 2; ++qt)
#pragma unroll
        for (int dt = 0; dt < 4; ++dt) Oa[qt][dt] = (f32x4){0.f, 0.f, 0.f, 0.f};
    float mrun[2] = {-1e30f, -1e30f}, lrun[2] = {0.f, 0.f};
    const int nds = t.nd >> 5, nsteps = nds + (t.nb == 1 ? 16 : 0);
    int rs = t.r - 4; rs = rs < 0 ? 0 : (rs > 24 ? 24 : rs);
    auto srcK = [&](int s) -> const bf16_t* { if (s < nds) return t.Kd + (size_t)s * 32 * OD_IN; const int u = s - nds; return t.Kn + (size_t)((rs + (u >> 1)) * 64 + (u & 1) * 32) * OD_IN; };
    auto srcV = [&](int s) -> const bf16_t* { if (s < nds) return t.VTd + s * 32; const int u = s - nds; return t.VTn + ((rs + (u >> 1)) * 64 + (u & 1) * 32); };
    bf16x8 KA[2][2], VA[4], KB[2][2], VB[4];
    attn_load(srcK(0), srcV(0), KA, VA, q, g);
    for (int s = 0; s < nsteps; s += 2) {
        attn_load(srcK(s + 1), srcV(s + 1), KB, VB, q, g);
        { const bool nbr = s >= nds; const int u = s - nds;
          attn_compute(KA, VA, Qf, Oa, mrun, lrun, q, g, nbr, t.qc0, (u & 1) * 32, t.rpb + (rs + (u >> 1) - t.r + 7) * 31, a32); }
        if (s + 2 < nsteps) attn_load(srcK(s + 2), srcV(s + 2), KA, VA, q, g);
        { const bool nbr = s + 1 >= nds; const int u = s + 1 - nds;
          attn_compute(KB, VB, Qf, Oa, mrun, lrun, q, g, nbr, t.qc0, (u & 1) * 32, t.rpb + (rs + (u >> 1) - t.r + 7) * 31, a32); }
    }
#pragma unroll
    for (int qt = 0; qt < 2; ++qt) {
        float l = lrun[qt]; l += shx16(l); l += shx32(l, a32);
        const float inv = 1.0f / l;
#pragma unroll
        for (int dt = 0; dt < 4; ++dt) { const f32x4 o = Oa[qt][dt] * inv; u32x2 w; w.x = pk2(o[0], o[1]); w.y = pk2(o[2], o[3]);
            *(u32x2*)(t.Y + (size_t)(16 * qt + q) * D + 16 * dt + 4 * g) = w; }
    }
}
__device__ __forceinline__ void gqa_block(const bf16_t* Qw, const bf16_t* Kd, const bf16_t* VTd, int nd, bf16_t* Yw, bf16_t* sKV, int tid, int lane, int a32) {
    const int q = lane & 15, g = lane >> 4;
    bf16x8 Qf[2][2];
#pragma unroll
    for (int qt = 0; qt < 2; ++qt)
#pragma unroll
        for (int ks = 0; ks < 2; ++ks) Qf[qt][ks] = *(const bf16x8*)(Qw + (size_t)(16 * qt + q) * OD_IN + 32 * ks + 8 * g);
    f32x4 Oa[2][4];
#pragma unroll
    for (int qt = 0; qt < 2; ++qt)
#pragma unroll
        for (int dt = 0; dt < 4; ++dt) Oa[qt][dt] = (f32x4){0.f, 0.f, 0.f, 0.f};
    float mrun[2] = {-1e30f, -1e30f}, lrun[2] = {0.f, 0.f};
    const int ntiles = nd >> 6;
    const int srow = tid >> 3, sch = (tid & 7) * 8;
    const bf16_t* kg_ = Kd + (size_t)srow * OD_IN + sch; const bf16_t* vg_ = VTd + (size_t)srow * TT + sch;
    bf16_t* sK = sKV; bf16_t* sV = sKV + 2 * 64 * 72;
    u32x4 pkA = *(const u32x4*)kg_, pvA = *(const u32x4*)vg_;
    u32x4 pkB = *(const u32x4*)(kg_ + (size_t)64 * OD_IN), pvB = *(const u32x4*)(vg_ + 64);
    __syncthreads();
    *(u32x4*)(sK + srow * 72 + sch) = pkA; *(u32x4*)(sV + srow * 72 + sch) = pvA;
    if (2 < ntiles) { pkA = *(const u32x4*)(kg_ + (size_t)2 * 64 * OD_IN); pvA = *(const u32x4*)(vg_ + 2 * 64); }
    __syncthreads();
    auto compute_tile = [&](int buf) {
        const bf16_t* bK = sK + buf * 64 * 72; const bf16_t* bV = sV + buf * 64 * 72;
#pragma unroll
        for (int ss = 0; ss < 2; ++ss) {
            bf16x8 Kf[2][2], Vf[4];
#pragma unroll
            for (int kt = 0; kt < 2; ++kt)
#pragma unroll
                for (int ks = 0; ks < 2; ++ks) Kf[kt][ks] = *(const bf16x8*)(bK + (32 * ss + 16 * kt + q) * 72 + 32 * ks + 8 * g);
#pragma unroll
            for (int dt = 0; dt < 4; ++dt) { const bf16_t* vp = bV + (16 * dt + q) * 72 + 32 * ss + 4 * g;
                const u32x2 lo = *(const u32x2*)vp, hi = *(const u32x2*)(vp + 16);
                u32x4 w; w.x = lo.x; w.y = lo.y; w.z = hi.x; w.w = hi.y; Vf[dt] = __builtin_bit_cast(bf16x8, w); }
            attn_compute(Kf, Vf, Qf, Oa, mrun, lrun, q, g, false, 0, 0, nullptr, a32);
        }
    };
    for (int i = 0; i < ntiles; i += 2) {
        compute_tile(0);
        *(u32x4*)(sK + 64 * 72 + srow * 72 + sch) = pkB; *(u32x4*)(sV + 64 * 72 + srow * 72 + sch) = pvB;
        if (i + 3 < ntiles) { pkB = *(const u32x4*)(kg_ + (size_t)(i + 3) * 64 * OD_IN); pvB = *(const u32x4*)(vg_ + (i + 3) * 64); }
        __syncthreads();
        compute_tile(1);
        if (i + 2 < ntiles) { *(u32x4*)(sK + srow * 72 + sch) = pkA; *(u32x4*)(sV + srow * 72 + sch) = pvA; }
        if (i + 4 < ntiles) { pkA = *(const u32x4*)(kg_ + (size_t)(i + 4) * 64 * OD_IN); pvA = *(const u32x4*)(vg_ + (i + 4) * 64); }
        __syncthreads();
    }
#pragma unroll
    for (int qt = 0; qt < 2; ++qt) {
        float l = lrun[qt]; l += shx16(l); l += shx32(l, a32);
        const float inv = 1.0f / l;
#pragma unroll
        for (int dt = 0; dt < 4; ++dt) { const f32x4 o = Oa[qt][dt] * inv; u32x2 w; w.x = pk2(o[0], o[1]); w.y = pk2(o[2], o[3]);
            *(u32x2*)(Yw + (size_t)(16 * qt + q) * D + 16 * dt + 4 * g) = w; }
    }
}
__device__ __forceinline__ void na_block(const bf16_t* Qw, const bf16_t* Kb, const bf16_t* VTb, int r, int hw, int qc0, const float* rpbh, bf16_t* Yw, bf16_t* sKV, int tid, int lane, int a32) {
    const int q = lane & 15, g = lane >> 4;
    bf16x8 Qf[2][2];
#pragma unroll
    for (int qt = 0; qt < 2; ++qt)
#pragma unroll
        for (int ks = 0; ks < 2; ++ks) Qf[qt][ks] = *(const bf16x8*)(Qw + (size_t)(16 * qt + q) * OD_IN + 32 * ks + 8 * g);
    f32x4 Oa[2][4];
#pragma unroll
    for (int qt = 0; qt < 2; ++qt)
#pragma unroll
        for (int dt = 0; dt < 4; ++dt) Oa[qt][dt] = (f32x4){0.f, 0.f, 0.f, 0.f};
    float mrun[2] = {0.f, 0.f}, lrun[2] = {0.f, 0.f};
    int rs = r - 4; rs = rs < 0 ? 0 : (rs > 24 ? 24 : rs);
    const int kh0 = tid >> 8, krow = (tid >> 3) & 31, kpart = (tid & 7) * 8;
    const int vrow = (tid >> 2) & 63, vpart = (tid & 3) * 8;
    const bf16_t* kg0 = Kb + (size_t)krow * OD_IN + kh0 * 64 + kpart; const bf16_t* vg0 = VTb + ((size_t)kh0 * 64 + vrow) * TT + vpart;
    bf16_t* sK = sKV; bf16_t* sV = sKV + 2 * 4 * 32 * 72;
    const int skoff = (kh0 * 32 + krow) * 72 + kpart, svoff = (kh0 * 64 + vrow) * 40 + vpart;
    auto koff = [&](int s) -> int { return s < 8 ? 32 * s : CL + (rs + ((s - 8) >> 1)) * 64 + ((s - 8) & 1) * 32; };
#define NA_LOAD(P, s) { const int ko_ = koff(s); P##k0 = *(const u32x4*)(kg0 + (size_t)ko_ * OD_IN); P##k1 = *(const u32x4*)(kg0 + (size_t)ko_ * OD_IN + 128); P##v0 = *(const u32x4*)(vg0 + ko_); P##v1 = *(const u32x4*)(vg0 + (size_t)128 * TT + ko_); }
#define NA_STORE(P, buf) { *(u32x4*)(sK + (buf) * 4 * 32 * 72 + skoff) = P##k0; *(u32x4*)(sK + (buf) * 4 * 32 * 72 + skoff + 2 * 32 * 72) = P##k1; \
        *(u32x4*)(sV + (buf) * 4 * 64 * 40 + svoff) = P##v0; *(u32x4*)(sV + (buf) * 4 * 64 * 40 + svoff + 2 * 64 * 40) = P##v1; }
    u32x4 Ak0, Ak1, Av0, Av1;
    NA_LOAD(A, 0)
    __syncthreads();
    NA_STORE(A, 0)
    NA_LOAD(A, 1)
    __syncthreads();
    auto compute_step = [&](int buf, int s) {
        const bf16_t* bK = sK + (buf * 4 + hw) * 32 * 72; const bf16_t* bV = sV + (buf * 4 + hw) * 64 * 40;
        bf16x8 Kf[2][2], Vf[4];
#pragma unroll
        for (int kt = 0; kt < 2; ++kt)
#pragma unroll
            for (int ks = 0; ks < 2; ++ks) Kf[kt][ks] = *(const bf16x8*)(bK + (16 * kt + q) * 72 + 32 * ks + 8 * g);
#pragma unroll
        for (int dt = 0; dt < 4; ++dt) { const bf16_t* vp = bV + (16 * dt + q) * 40 + 4 * g;
            const u32x2 lo = *(const u32x2*)vp, hi = *(const u32x2*)(vp + 16);
            u32x4 w; w.x = lo.x; w.y = lo.y; w.z = hi.x; w.w = hi.y; Vf[dt] = __builtin_bit_cast(bf16x8, w); }
        const int u = s - 8;
        attn_compute(Kf, Vf, Qf, Oa, mrun, lrun, q, g, s >= 8, qc0, (u & 1) * 32, rpbh + (rs + (u >> 1) - r + 7) * 31, a32);
    };
#pragma unroll 1
    for (int s = 0; s < 24; ++s) {
        const int buf = s & 1;
        compute_step(buf, s);
        if (s + 1 < 24) NA_STORE(A, buf ^ 1)
        if (s + 2 < 24) NA_LOAD(A, s + 2)
        __syncthreads();
    }
#undef NA_LOAD
#undef NA_STORE
#pragma unroll
    for (int qt = 0; qt < 2; ++qt) {
        float l = lrun[qt]; l += shx16(l); l += shx32(l, a32);
        const float inv = 1.0f / l;
#pragma unroll
        for (int dt = 0; dt < 4; ++dt) { const f32x4 o = Oa[qt][dt] * inv; u32x2 w; w.x = pk2(o[0], o[1]); w.y = pk2(o[2], o[3]);
            *(u32x2*)(Yw + (size_t)(16 * qt + q) * D + 16 * dt + 4 * g) = w; }
    }
}
__device__ __forceinline__ void odd_attn_phase(const Params& p, int j, bool need_ctx, const bf16_t* Z, const bf16_t* VTG, const bf16_t* VTN, bf16_t* Y, float* sRpb) {
    const int tid = tid_(), wid = __builtin_amdgcn_readfirstlane(tid >> 6), lane = tid & 63; const int b0_ = bid_(), gd_ = gdim_(); const int a32 = x32addr_();
    __syncthreads();
    { const float* prpb = inp(30) + (size_t)j * 8 * 465; for (int idx = tid; idx < 8 * 465; idx += 512) sRpb[idx] = prpb[idx] * 1.4426950408889634f; }
    __syncthreads();
    const int ntask = 4096 + (need_ctx ? 512 : 0);
    for (int task = b0_; task < ntask; task += gd_) {
        AttnTask t; t.nb = 0; t.Kn = nullptr; t.VTn = nullptr; t.r = 0; t.qc0 = 0; t.rpb = sRpb;
        if (task < 2048) {
            const int b = task >> 6, kvh = (task >> 5) & 1, qb = task & 31, hq = kvh * 4 + (wid >> 1), qh = wid & 1;
            const size_t row = (size_t)b * TT + CL + qb * 64 + qh * 32;
            t.Q = Z + row * OD_IN + hq * 64; t.Kd = Z + (size_t)b * TT * OD_IN + 512 + kvh * 64; t.VTd = VTG + (size_t)(b * 2 + kvh) * 64 * TT; t.nd = TT;
            t.Y = Y + row * D + hq * 64; t.nb = 2;
        } else if (task < 4096) {
            const int tk = task - 2048; const int b = tk >> 6, r = (tk >> 1) & 31, h = (tk & 1) * 4 + (wid >> 1), qh = wid & 1;
            const size_t row = (size_t)b * TT + CL + r * 64 + qh * 32;
            t.Q = Z + row * OD_IN + 768 + h * 64; t.Kd = Z + (size_t)b * TT * OD_IN + 1280 + h * 64; t.VTd = VTN + (size_t)(b * 8 + h) * 64 * TT; t.nd = CL;
            t.Kn = t.Kd + (size_t)CL * OD_IN; t.VTn = t.VTd + CL; t.nb = 1; t.r = r; t.qc0 = qh * 32; t.rpb = sRpb + h * 465;
            t.Y = Y + row * D + 512 + h * 64;
        } else if (task < 4352) {
            const int tk = task - 4096; const int b = tk >> 3, kvh = (tk >> 2) & 1, qb = tk & 3, hq = kvh * 4 + (wid >> 1), qh = wid & 1;
            const size_t row = (size_t)b * TT + qb * 64 + qh * 32;
            t.Q = Z + row * OD_IN + hq * 64; t.Kd = Z + (size_t)b * TT * OD_IN + 512 + kvh * 64; t.VTd = VTG + (size_t)(b * 2 + kvh) * 64 * TT; t.nd = CL;
            t.Y = Y + row * D + hq * 64; t.nb = 2;
        } else {
            const int tk = task - 4352; const int b = tk >> 3, qblk = tk & 7, h = wid;
            const size_t row = (size_t)b * TT + qblk * 32;
            t.Q = Z + row * OD_IN + 768 + h * 64; t.Kd = Z + (size_t)b * TT * OD_IN + 1280 + h * 64; t.VTd = VTN + (size_t)(b * 8 + h) * 64 * TT; t.nd = CL;
            t.Y = Y + row * D + 512 + h * 64;
        }
        if (t.nb == 2) gqa_block(t.Q, t.Kd, t.VTd, t.nd, t.Y, (bf16_t*)(sRpb + 4096), tid, lane, a32);
        else if (t.nb == 1) { const int tk = task - 2048; const int b = tk >> 6, hg4 = (tk & 1) * 4;
            na_block(t.Q, Z + (size_t)b * TT * OD_IN + 1280 + hg4 * 64, VTN + (size_t)(b * 8 + hg4) * 64 * TT, t.r, wid >> 1, t.qc0, t.rpb, t.Y, (bf16_t*)(sRpb + 4096), tid, lane, a32); }
        else attn_wave(t, lane, a32);
    }
}

#define XB_TMO      128
#define XB_XCNT(j)  (256  + 64 * (j))
#define XB_XSUB(j)  (1280 + 64 * (j))
#define XB_XGEN(j)  (2304 + 64 * (j))
#define XB_TOP      3328
#define XB_TOPGEN   3392
#define XCD_BAR_WORDS 3456
#define XB_SPIN_CAP (1u << 22)
__device__ __forceinline__ unsigned xb_ld(unsigned* p)              { return __hip_atomic_load(p, __ATOMIC_RELAXED, __HIP_MEMORY_SCOPE_AGENT); }
__device__ __forceinline__ unsigned xb_add(unsigned* p, unsigned v) { return __hip_atomic_fetch_add(p, v, __ATOMIC_RELAXED, __HIP_MEMORY_SCOPE_AGENT); }
__device__ __forceinline__ unsigned xb_xcc_id() { return (unsigned)__builtin_amdgcn_s_getreg((3 << 11) | 20) & 0xFu; }
#define XB_SPIN(cond, bar) do { unsigned _sp = 0; while (cond) { __builtin_amdgcn_s_sleep(1); \
    if ((++_sp & 255u) == 0u) { if (xb_ld(&(bar)[XB_TMO])) break; if (_sp > XB_SPIN_CAP) { atomicAdd(&(bar)[XB_TMO], 1u); break; } } } } while (0)
__device__ __forceinline__ void xcd_barrier_complete(unsigned* bar, unsigned x, unsigned& nloc, unsigned& nx) {
    const unsigned G = gridDim.x;
    unsigned sum, cnt, mine, sp = 0u;
    for (;;) {
        sum = 0u; cnt = 0u; mine = 0u;
#pragma unroll
        for (unsigned j = 0; j < 16; ++j) { const unsigned c = xb_ld(&bar[XB_XCNT(j)]); sum += c; cnt += (c > 0u) ? 1u : 0u; mine = (j == x) ? c : mine; }
        if (sum == G) break;
        __builtin_amdgcn_s_sleep(1);
        if ((++sp & 255u) == 0u) { if (xb_ld(&bar[XB_TMO])) break; if (sp > XB_SPIN_CAP) { atomicAdd(&bar[XB_TMO], 1u); break; } }
    }
    nloc = mine > 0u ? mine : 1u; nx = cnt > 0u ? cnt : 1u;
}
__device__ __forceinline__ void gbar(unsigned* bar, volatile LAS unsigned* st) {
    asm volatile("s_waitcnt vmcnt(0)" ::: "memory");
    __syncthreads();
    if (threadIdx.x == 0) {
        __builtin_amdgcn_s_waitcnt(0);
        const unsigned x = xb_xcc_id();
        unsigned nloc = st[0], nx = st[1];
        if (nloc == 0u) { xcd_barrier_complete(bar, x, nloc, nx); st[0] = nloc; st[1] = nx; }
        const unsigned old = xb_add(&bar[XB_XSUB(x)], 1u);
        const unsigned gen = old / nloc;
        if (old + 1u == (gen + 1u) * nloc) {
            __builtin_amdgcn_fence(__ATOMIC_RELEASE, "agent");
            asm volatile("s_waitcnt vmcnt(0)" ::: "memory");
            const unsigned og = xb_add(&bar[XB_TOP], 1u);
            const unsigned tg = og / nx;
            if (og + 1u == (tg + 1u) * nx) xb_add(&bar[XB_TOPGEN], 1u);
            else XB_SPIN(xb_ld(&bar[XB_TOPGEN]) == tg, bar);
            __builtin_amdgcn_fence(__ATOMIC_ACQUIRE, "agent");
            xb_add(&bar[XB_XGEN(x)], 1u);
            asm volatile("s_waitcnt vmcnt(0)" ::: "memory");
        } else {
            XB_SPIN(xb_ld(&bar[XB_XGEN(x)]) == gen, bar);
            __builtin_amdgcn_fence(__ATOMIC_ACQUIRE, "agent");
            asm volatile("s_waitcnt vmcnt(0)" ::: "memory");
        }
    }
    __syncthreads();
}
constexpr size_t OFF_BAR = OFF_MOD + 3670016;
__global__ void __launch_bounds__(512, 2) mega(Params p) {
    extern __shared__ __attribute__((aligned(16))) unsigned char lds_raw[];
    cg::grid_group grid = cg::this_grid();
    float* smf = (float*)lds_raw;
    LAS unsigned char* ldsg = (LAS unsigned char*)lds_raw;
    if (blockIdx.x == 0) { unsigned* bw = (unsigned*)(wsp() + OFF_BAR); for (int i = threadIdx.x; i < XCD_BAR_WORDS; i += 512) __hip_atomic_store(bw + i, 0u, __ATOMIC_RELAXED, __HIP_MEMORY_SCOPE_AGENT); }
    volatile LAS unsigned* bar_st = (volatile LAS unsigned*)(ldsg + LDS_BYTES - 16);
    if (threadIdx.x == 0) { bar_st[0] = 0u; bar_st[1] = 0u; }
    for (int l = 0; l < 4; ++l) {
        const int j = l >> 1; unsigned char* wl = wsp() + OFF_W + (size_t)l * WL_BYTES;
        if ((l & 1) == 0) { convert_matrix(inp(10) + (size_t)j * D * EV_IN, D, EV_IN, EV_INP, 0, (bf16_t*)(wl + WO_IN), smf);
                            convert_matrix(inp(11) + (size_t)j * D * D, D, D, D, 0, (bf16_t*)(wl + WO_OUT), smf); }
        else              { convert_matrix(inp(26) + (size_t)j * D * OD_IN, D, OD_IN, OD_IN, 0, (bf16_t*)(wl + WO_IN), smf);
                            convert_matrix(inp(27) + (size_t)j * D * D, D, D, D, 0, (bf16_t*)(wl + WO_OUT), smf); }
        convert_matrix(inp(8) + (size_t)l * D * NFF, D, NFF, NFF, 1, (bf16_t*)(wl + WO_W13), smf);
        convert_matrix(inp(9) + (size_t)l * DFF * D, DFF, D, D, 0, (bf16_t*)(wl + WO_W2), smf);
    }
    { const int b0_ = bid_(), gd_ = gdim_(); for (int item = b0_; item < 192; item += gd_) mod_item(p, item, smf, smf + 33 * 256); }
    grid.sync();
    if (threadIdx.x == 0) (void)xb_add(&((unsigned*)(wsp() + OFF_BAR))[XB_XCNT(xb_xcc_id())], 1u);

#define WS_ (wsp())
#define MODL_ ((const float*)(WS_ + OFF_MOD) + (size_t)l * 33 * 6144)
#define WL_ (WS_ + OFF_W + (size_t)l * WL_BYTES)
#define HB_ ((bf16_t*)(WS_ + OFF_H))
#define CTXX_ ((float*)(WS_ + OFF_CTXX))
    for (int l = 0; l < 4; ++l) {
        const int j = l >> 1; const bool even = (l & 1) == 0;
        norm_phase((l == 0) ? inp(0) : (const float*)outp(), (l == 0) ? inp(2) : (const float*)CTXX_, inp(6) + l * D, MODL_, 0, 1024, HB_);
        gbar((unsigned*)(wsp() + OFF_BAR), bar_st);
        if (even) {
            for (int hb = 0; hb < 2; ++hb) {
                { unsigned char* R = WS_ + OFF_R;
                  pg8::Gemm g{HB_ + (size_t)hb * HROWS * D, (const bf16_t*)(WL_ + WO_IN), HROWS, EV_INP, D};
                  pg8::StaticOrder S; S.init(HROWS, EV_INP, gdim_(), bid_());
                  EpiZ E{(bf16_t*)R, EV_INP};
                  pg8::gemm_phase<EpiZ>(ldsg, g, S, E); }
                gbar((unsigned*)(wsp() + OFF_BAR), bar_st);
                for (int rep_ = 0; rep_ < REP_FEAT; ++rep_) { unsigned char* R = WS_ + OFF_R; even_feat_phase(p, j, (const bf16_t*)R, (bf16_t*)(R + RO_F), smf); }
                gbar((unsigned*)(wsp() + OFF_BAR), bar_st);
                for (int rep_ = 0; rep_ < REP_RWKV; ++rep_) { unsigned char* R = WS_ + OFF_R; rwkv_scan_phase((const bf16_t*)(R + RO_F), (bf16_t*)(R + RO_O), smf); }
                for (int rep_ = 0; rep_ < REP_GLA; ++rep_) { unsigned char* R = WS_ + OFF_R; gla_phase(p, j, (const bf16_t*)R, (bf16_t*)(R + RO_O), smf); }
                gbar((unsigned*)(wsp() + OFF_BAR), bar_st);
                { unsigned char* R = WS_ + OFF_R; even_merge_phase(p, j, (const bf16_t*)R, (const bf16_t*)(R + RO_F), (const bf16_t*)(R + RO_O), HB_ + (size_t)hb * HROWS * D); }
                gbar((unsigned*)(wsp() + OFF_BAR), bar_st);
            }
        } else {
            { unsigned char* R = WS_ + OFF_R;
              pg8::Gemm g{HB_, (const bf16_t*)(WL_ + WO_IN), MROWS, OD_IN, D};
              pg8::StaticOrder S; S.init(MROWS, OD_IN, gdim_(), bid_());
              EpiZ E{(bf16_t*)R, OD_IN};
              pg8::gemm_phase<EpiZ>(ldsg, g, S, E); }
            gbar((unsigned*)(wsp() + OFF_BAR), bar_st);
            { unsigned char* R = WS_ + OFF_R; odd_feat_phase(p, j, (bf16_t*)R, (bf16_t*)(R + RO_VTG), (bf16_t*)(R + RO_VTN), smf); }
            gbar((unsigned*)(wsp() + OFF_BAR), bar_st);
            for (int rep_ = 0; rep_ < REP_ATTN; ++rep_) { unsigned char* R = WS_ + OFF_R; odd_attn_phase(p, j, l < 3, (const bf16_t*)R, (const bf16_t*)(R + RO_VTG), (const bf16_t*)(R + RO_VTN), HB_, smf); }
            gbar((unsigned*)(wsp() + OFF_BAR), bar_st);
        }
        { pg8::Gemm g{HB_, (const bf16_t*)(WL_ + WO_OUT), MROWS, D, D};
          pg8::StaticOrder S; S.init(MROWS, D, gdim_(), bid_(), l == 3);
          EpiRes E{(l == 0) ? inp(0) : (const float*)outp(), (l == 0) ? inp(2) : (const float*)CTXX_, outp(), CTXX_, MODL_, 2048};
          pg8::gemm_phase<EpiRes>(ldsg, g, S, E); }
        gbar((unsigned*)(wsp() + OFF_BAR), bar_st);
        norm_phase(outp(), CTXX_, inp(7) + l * D, MODL_, 3072, 4096, HB_);
        gbar((unsigned*)(wsp() + OFF_BAR), bar_st);
        for (int rep_ = 0; rep_ < REP_FFNUP; ++rep_) { pg8::Gemm g{HB_, (const bf16_t*)(WL_ + WO_W13), MROWS, NFF, D};
          pg8::StaticOrder S; S.init(MROWS, NFF, gdim_(), bid_(), l == 3);
          EpiSwi E{(bf16_t*)(WS_ + OFF_R)};
          pg8::gemm_phase<EpiSwi>(ldsg, g, S, E); }
        gbar((unsigned*)(wsp() + OFF_BAR), bar_st);
        { pg8::Gemm g{(const bf16_t*)(WS_ + OFF_R), (const bf16_t*)(WL_ + WO_W2), MROWS, D, DFF};
          pg8::StaticOrder S; S.init(MROWS, D, gdim_(), bid_(), l == 3);
          EpiRes E{outp(), CTXX_, outp(), CTXX_, MODL_, 5120};
          pg8::gemm_phase<EpiRes>(ldsg, g, S, E); }
        gbar((unsigned*)(wsp() + OFF_BAR), bar_st);
    }
    float* xfin = outp(); const float* gfin = inp(31);
    const int tid = tid_(), lane = tid & 63, gw = bid_() * 8 + (tid >> 6), nw = gdim_() * 8; const int a32 = x32addr_();
    for (int r4 = gw; r4 < NB * TL / 4; r4 += nw) {
        float* xr = xfin + (size_t)r4 * 4 * D;
        f32x4 v[4][4];
#pragma unroll
        for (int rr = 0; rr < 4; ++rr)
#pragma unroll
            for (int i = 0; i < 4; ++i) v[rr][i] = *(const f32x4*)(xr + (size_t)rr * D + i * 256 + lane * 4);
        f32x4 gg[4];
#pragma unroll
        for (int i = 0; i < 4; ++i) gg[i] = *(const f32x4*)(gfin + i * 256 + lane * 4);
#pragma unroll
        for (int rr = 0; rr < 4; ++rr) {
            float ss = 0.f;
#pragma unroll
            for (int i = 0; i < 4; ++i) ss += v[rr][i][0] * v[rr][i][0] + v[rr][i][1] * v[rr][i][1] + v[rr][i][2] * v[rr][i][2] + v[rr][i][3] * v[rr][i][3];
            ss = red64(ss, a32);
            const float rs = rsqrtf(ss * (1.0f / 1024.0f) + 1e-6f);
#pragma unroll
            for (int i = 0; i < 4; ++i) *(f32x4*)(xr + (size_t)rr * D + i * 256 + lane * 4) = v[rr][i] * rs * gg[i];
        }
    }
}

extern "C" void kernel_launch(void* const* d_in, const int* in_sizes, int n_in, void* d_out, int out_size, void* d_ws, size_t ws_size, hipStream_t stream) {
    static int grid_blocks = 0;
    if (!grid_blocks) {
        int dev = 0, cus = 0, per_cu = 0;
        (void)hipGetDevice(&dev);
        (void)hipDeviceGetAttribute(&cus, hipDeviceAttributeMultiprocessorCount, dev);
        (void)hipFuncSetAttribute((const void*)mega, hipFuncAttributeMaxDynamicSharedMemorySize, LDS_BYTES);
        (void)hipOccupancyMaxActiveBlocksPerMultiprocessor(&per_cu, (const void*)mega, 512, LDS_BYTES);
        if (per_cu < 1) per_cu = 1;
        grid_blocks = cus * per_cu;
        if (ws_size < WS_NEED || n_in != 32) { fprintf(stderr, "kernel_launch: workspace %zu < %zu or n_in %d != 32\n", ws_size, (size_t)WS_NEED, n_in); grid_blocks = -1; }
    }
    if (grid_blocks < 0) return;
    Params p{};
    for (int i = 0; i < 32; ++i) p.in[i] = (const float*)d_in[i];
    p.out = (float*)d_out; p.ws = (unsigned char*)d_ws;
    void* args[] = {&p};
    hipError_t e = hipLaunchCooperativeKernel((void*)mega, dim3(grid_blocks), dim3(512), args, LDS_BYTES, stream);
    if (e != hipSuccess) fprintf(stderr, "cooperative launch failed: %s (grid %d)\n", hipGetErrorString(e), grid_blocks);
}
```

```cpp
#include <hip/hip_runtime.h>
#include <hip/hip_cooperative_groups.h>
#include <cstdio>
namespace cg = cooperative_groups;

#define LAS __attribute__((address_space(3)))
typedef unsigned short bf16_t;
typedef short bf16x8 __attribute__((ext_vector_type(8)));
typedef float f32x4 __attribute__((ext_vector_type(4)));
typedef float f32x2 __attribute__((ext_vector_type(2)));
typedef unsigned u32x4 __attribute__((ext_vector_type(4)));
typedef unsigned u32x2 __attribute__((ext_vector_type(2)));

constexpr int D = 1024, NB = 32, TL = 2048, CL = 256, TT = 2304, MROWS = NB * TT, HROWS = MROWS / 2;
constexpr int EV_IN = 3296, EV_INP = 3328, OD_IN = 2304, DFF = 2816, NFF = 5632;
constexpr int LDS_BYTES = 144 * 1024;
#ifndef REP_ATTN
#define REP_ATTN 1
#endif
#ifndef REP_RWKV
#define REP_RWKV 1
#endif
#ifndef REP_GLA
#define REP_GLA 1
#endif
#ifndef REP_FEAT
#define REP_FEAT 1
#endif
#ifndef REP_FFNUP
#define REP_FFNUP 1
#endif
constexpr size_t OFF_CTXX = 0, OFF_MOD = 33554432, OFF_W = 37748736, WL_BYTES = 26214400, OFF_H = 142606336, OFF_R = 293601280;
constexpr size_t WO_IN = 0, WO_OUT = 6815744, WO_W13 = 8912896, WO_W2 = 20447232;
constexpr size_t RO_F = 245366784, RO_O = 547356672;
constexpr size_t RO_VTG = 339738624, RO_VTN = 358612992;
constexpr size_t WS_NEED = OFF_R + 698351616;

struct Params { const float* in[32]; float* out; unsigned char* ws; };
typedef const __attribute__((address_space(4))) char* kaptr_t;
__device__ __forceinline__ kaptr_t kabase() { kaptr_t ka = (kaptr_t)__builtin_amdgcn_kernarg_segment_ptr(); asm volatile("" : "+s"(ka)); return ka; }
__device__ __forceinline__ const float* inp(int i) { return *(const float* const __attribute__((address_space(4)))*)(kabase() + 8 * i); }
__device__ __forceinline__ float* outp() { return *(float* const __attribute__((address_space(4)))*)(kabase() + 256); }
__device__ __forceinline__ unsigned char* wsp() { return *(unsigned char* const __attribute__((address_space(4)))*)(kabase() + 264); }

typedef float cvt_f32x2_t __attribute__((ext_vector_type(2)));
typedef __bf16 cvt_bf16x2_t __attribute__((ext_vector_type(2)));
__device__ __forceinline__ unsigned pk2(float lo, float hi) { const cvt_f32x2_t v = {lo, hi}; const cvt_bf16x2_t b = __builtin_convertvector(v, cvt_bf16x2_t); return __builtin_bit_cast(unsigned, b); }
__device__ __forceinline__ unsigned f2bf(float f) { return pk2(f, f) & 0xffffu; }
__device__ __forceinline__ float bflo(unsigned u) { return __builtin_bit_cast(float, u << 16); }
__device__ __forceinline__ float bfhi(unsigned u) { return __builtin_bit_cast(float, u & 0xffff0000u); }
__device__ __forceinline__ float bf1(bf16_t b) { return __builtin_bit_cast(float, ((unsigned)b) << 16); }
__device__ __forceinline__ void unpack8(u32x4 w, float* o) { o[0] = bflo(w.x); o[1] = bfhi(w.x); o[2] = bflo(w.y); o[3] = bfhi(w.y); o[4] = bflo(w.z); o[5] = bfhi(w.z); o[6] = bflo(w.w); o[7] = bfhi(w.w); }
__device__ __forceinline__ u32x4 pack8(const float* v) { u32x4 w; w.x = pk2(v[0], v[1]); w.y = pk2(v[2], v[3]); w.z = pk2(v[4], v[5]); w.w = pk2(v[6], v[7]); return w; }
__device__ __forceinline__ int tid_() { int t = threadIdx.x; asm volatile("" : "+v"(t)); return t; }
__device__ __forceinline__ int bid_() { int t = blockIdx.x; asm volatile("" : "+s"(t)); return t; }
__device__ __forceinline__ int gdim_() { int t = gridDim.x; asm volatile("" : "+s"(t)); return t; }
__device__ __forceinline__ float sigmoidf_(float x) { return __builtin_amdgcn_rcpf(1.0f + __expf(-x)); }
__device__ __forceinline__ float siluf_(float x) { return x * __builtin_amdgcn_rcpf(1.0f + __expf(-x)); }
template <int CTRL> __device__ __forceinline__ float dppf(float x) { return __builtin_bit_cast(float, __builtin_amdgcn_mov_dpp(__builtin_bit_cast(int, x), CTRL, 0xf, 0xf, true)); }
__device__ __forceinline__ float red8(float x) { x += dppf<0xB1>(x); x += dppf<0x4E>(x); x += dppf<0x141>(x); return x; }
__device__ __forceinline__ int x32addr_() { int l = __builtin_amdgcn_mbcnt_hi(-1, __builtin_amdgcn_mbcnt_lo(-1, 0)); asm volatile("" : "+v"(l)); return (l ^ 32) << 2; }
__device__ __forceinline__ float shx2(float x) { return dppf<0x4E>(x); }
__device__ __forceinline__ float shx8(float x) { return dppf<0x128>(x); }
__device__ __forceinline__ float shx16(float x) { return __builtin_bit_cast(float, __builtin_amdgcn_ds_swizzle(__builtin_bit_cast(int, x), 0x401F)); }
__device__ __forceinline__ float shx32(float x, int a32) { return __builtin_bit_cast(float, __builtin_amdgcn_ds_bpermute(a32, __builtin_bit_cast(int, x))); }
__device__ __forceinline__ float red16(float x) { x = red8(x); x += shx8(x); return x; }
__device__ __forceinline__ float red64(float x, int a32) { x = red16(x); x += shx16(x); x += shx32(x, a32); return x; }

namespace pg8 {
constexpr int BM = 256, BK = 64, HALF = 128, HTB = HALF * BK * 2, STAGE_BYTES = 8 * HTB, NXCD = 8, WGM = 8;
__device__ __forceinline__ int lds_byte(int r, int c) { const int st = (r >> 4) * 2 + (c >> 5), rr = r & 15, cc = c & 31, ob = rr * 64 + cc * 2; return st * 1024 + (ob ^ (((ob >> 9) & 1) << 5)); }
__device__ __forceinline__ void stage_rc(int b, int& R, int& C) { const int st = b / 1024, sb = b % 1024, swz = sb ^ (((sb >> 9) & 1) << 5); R = (st >> 1) * 16 + swz / 64; C = (st & 1) * 32 + (swz % 64) / 2; }
__device__ __forceinline__ int perm32(int rho) { const int n = rho >> 4, i = rho & 15; return 8 * (i >> 2) + 4 * n + (i & 3); }
struct Unit { int pm, pn; };
struct Gemm { const bf16_t* A; const bf16_t* Bt; int M, N, K; };
struct StaticOrder {
    int nM, nN, nwg, G, c, skip;
    __device__ void init(int M, int N, int G_, int c_, int skip_ = 0) { skip = skip_; nM = skip_ ? NB * 8 : M / BM; nN = N / BM; nwg = nM * nN; G = G_; c = c_; }
    __device__ bool next(int i, Unit& u) const {
        const long L = (long)i * G + c; if (L >= nwg) return false;
        int wgid = (int)L; { const int q = nwg / NXCD, r = nwg % NXCD, xcd = wgid % NXCD, off = wgid / NXCD; wgid = (xcd < r ? xcd * (q + 1) : r * (q + 1) + (xcd - r) * q) + off; }
        const int nig = WGM * nN, gid = wgid / nig, fm = gid * WGM, gsz = (nM - fm) < WGM ? (nM - fm) : WGM;
        u.pm = fm + ((wgid % nig) % gsz); u.pn = (wgid % nig) / gsz; if (skip) u.pm = (u.pm >> 3) * 9 + 1 + (u.pm & 7); return true;
    }
};
template <class Epi>
__device__ __forceinline__ void gemm_phase(LAS unsigned char* lds, const Gemm g, const StaticOrder& S, const Epi& E) {
    const int tid = tid_(), wid = __builtin_amdgcn_readfirstlane(tid >> 6), lane = tid & 63, wr = wid >> 2, wc = wid & 3, fr = lane & 15, fq = lane >> 4;
    const int K = g.K, nt = K / BK;
    unsigned voffA[2], voffB[2];
#pragma unroll
    for (int i = 0; i < 2; ++i) { int R, C; stage_rc(tid * 16 + i * 8192, R, C); const int Rb = Epi::PERM ? ((R & ~31) + perm32(R & 31)) : R;
        voffA[i] = (unsigned)(R * K + C) * 2u; voffB[i] = (unsigned)(Rb * K + C) * 2u; }
    const size_t kstep = (size_t)(BK * 2);
    const size_t hstep = (size_t)HALF * K * 2;
    const size_t tstep = 2 * hstep;
    const unsigned ldsw = (unsigned)wid * 1024u;
    const int aoff = lds_byte(wr * 64 + fr, fq * 8), boff = lds_byte(wc * 32 + fr, fq * 8);
#define PG8_SA(b, h) (((b) * 2 + (h)) * HTB)
#define PG8_SB(b, h) ((4 + (b) * 2 + (h)) * HTB)
#define PG8_STAGE(bufoff, gbase, voff) do { _Pragma("unroll") for (int _i = 0; _i < 2; ++_i) \
        __builtin_amdgcn_global_load_lds((const unsigned*)((const char*)(gbase) + (voff)[_i]), (LAS unsigned*)(lds + (bufoff) + ldsw + _i * 8192), 16, 0, 0); } while (0)
#define PG8_LDA(dst, b, h) do { _Pragma("unroll") for (int m = 0; m < 4; ++m) _Pragma("unroll") for (int k = 0; k < 2; ++k) dst[m][k] = *(const LAS bf16x8*)(lds + PG8_SA(b, h) + aoff + m * 2048 + k * 1024); } while (0)
#define PG8_LDB(dst, b, h) do { _Pragma("unroll") for (int n = 0; n < 2; ++n) _Pragma("unroll") for (int k = 0; k < 2; ++k) dst[n][k] = *(const LAS bf16x8*)(lds + PG8_SB(b, h) + boff + n * 2048 + k * 1024); } while (0)
#define PG8_MMA(ai, bj, At, Bt) do { __builtin_amdgcn_s_setprio(1); _Pragma("unroll") for (int m = 0; m < 4; ++m) _Pragma("unroll") for (int n = 0; n < 2; ++n) _Pragma("unroll") for (int k = 0; k < 2; ++k) \
        acc[ai][bj][m][n] = __builtin_amdgcn_mfma_f32_16x16x32_bf16(Bt[n][k], At[m][k], acc[ai][bj][m][n], 0, 0, 0); __builtin_amdgcn_s_setprio(0); } while (0)
#define PG8_WAIT_V(n) asm volatile("s_waitcnt vmcnt(" #n ")" ::: "memory")
#define PG8_WAIT_L(n) asm volatile("s_waitcnt lgkmcnt(" #n ")" ::: "memory")
#define PG8_BAR __builtin_amdgcn_s_barrier()
#define PG8_SCHED __builtin_amdgcn_sched_barrier(0)
    Unit cur, nxt; int ui = 0;
    if (!S.next(0, cur)) return;
    f32x4 acc[2][2][4][2];
#pragma unroll
    for (int a = 0; a < 2; ++a)
#pragma unroll
        for (int b = 0; b < 2; ++b)
#pragma unroll
            for (int m = 0; m < 4; ++m)
#pragma unroll
                for (int n = 0; n < 2; ++n) acc[a][b][m][n] = (f32x4){0.f, 0.f, 0.f, 0.f};
    bf16x8 At[4][2], B0[2][2], B1[2][2];
    const char* cA = (const char*)g.A + (size_t)cur.pm * tstep; const char* cB = (const char*)g.Bt + (size_t)cur.pn * tstep;
    PG8_STAGE(PG8_SB(0, 0), cB, voffB); PG8_STAGE(PG8_SB(0, 1), cB + hstep, voffB); PG8_STAGE(PG8_SA(0, 0), cA, voffA); PG8_STAGE(PG8_SA(0, 1), cA + hstep, voffA);
    if (wr == 1) PG8_BAR;
    PG8_WAIT_V(2); PG8_BAR;
    PG8_STAGE(PG8_SB(1, 0), cB + kstep, voffB); PG8_STAGE(PG8_SA(1, 0), cA + kstep, voffA); PG8_STAGE(PG8_SB(1, 1), cB + hstep + kstep, voffB);
    PG8_WAIT_V(6); PG8_BAR;
    for (;;) {
        const bool has_next = S.next(ui + 1, nxt);
        const char* nA = has_next ? (const char*)g.A + (size_t)nxt.pm * tstep : cA; const char* nB = has_next ? (const char*)g.Bt + (size_t)nxt.pn * tstep : cB;
        for (int t = 0; t < nt; t += 2) {
            const bool last = (t == nt - 2);
            const char* a1 = cA + (size_t)(t + 1) * kstep;
            const char* a2 = last ? nA : cA + (size_t)(t + 2) * kstep; const char* b2 = last ? nB : cB + (size_t)(t + 2) * kstep;
            const char* a3 = a2 + kstep; const char* b3 = b2 + kstep;
            PG8_LDB(B0, 0, 0); PG8_LDB(B1, 0, 1); PG8_SCHED; PG8_LDA(At, 0, 0); PG8_STAGE(PG8_SA(1, 1), a1 + hstep, voffA);
            PG8_WAIT_V(8); PG8_WAIT_L(0); PG8_BAR; PG8_MMA(0, 0, At, B0); PG8_MMA(0, 1, At, B1); PG8_BAR; PG8_SCHED;
            PG8_LDA(At, 0, 1); PG8_STAGE(PG8_SB(0, 0), b2, voffB); PG8_STAGE(PG8_SB(0, 1), b2 + hstep, voffB); PG8_STAGE(PG8_SA(0, 0), a2, voffA);
            PG8_WAIT_V(8); PG8_WAIT_L(0); PG8_BAR; PG8_MMA(1, 0, At, B0); PG8_MMA(1, 1, At, B1); PG8_BAR; PG8_SCHED;
            PG8_LDB(B0, 1, 0); PG8_LDB(B1, 1, 1); PG8_SCHED; PG8_LDA(At, 1, 0); PG8_STAGE(PG8_SA(0, 1), a2 + hstep, voffA);
            PG8_WAIT_V(8); PG8_WAIT_L(0); PG8_BAR; PG8_MMA(0, 0, At, B0); PG8_MMA(0, 1, At, B1); PG8_BAR; PG8_SCHED;
            PG8_LDA(At, 1, 1); PG8_STAGE(PG8_SB(1, 0), b3, voffB); PG8_STAGE(PG8_SB(1, 1), b3 + hstep, voffB); PG8_STAGE(PG8_SA(1, 0), a3, voffA);
            PG8_WAIT_V(8); PG8_WAIT_L(0); PG8_BAR; PG8_MMA(1, 0, At, B0); PG8_MMA(1, 1, At, B1); PG8_BAR; PG8_SCHED;
        }
        if (wr == 0) PG8_BAR;
        E(acc, cur, wr, wc, fr, fq);
        if (!has_next) break;
#pragma unroll
        for (int a = 0; a < 2; ++a)
#pragma unroll
            for (int b = 0; b < 2; ++b)
#pragma unroll
                for (int m = 0; m < 4; ++m)
#pragma unroll
                    for (int n = 0; n < 2; ++n) acc[a][b][m][n] = (f32x4){0.f, 0.f, 0.f, 0.f};
        cur = nxt; cA = nA; cB = nB; ++ui;
        if (wr == 1) PG8_BAR;
    }
    PG8_WAIT_V(0);
    PG8_BAR;
#undef PG8_SA
#undef PG8_SB
#undef PG8_STAGE
#undef PG8_LDA
#undef PG8_LDB
#undef PG8_MMA
#undef PG8_WAIT_V
#undef PG8_WAIT_L
#undef PG8_BAR
#undef PG8_SCHED
}
}

struct EpiZ {
    static constexpr bool PERM = true;
    bf16_t* O; int ldc;
    __device__ __forceinline__ void operator()(const f32x4 (&acc)[2][2][4][2], const pg8::Unit& u, int wr, int wc, int fr, int fq) const {
        const int row0 = u.pm * 256 + wr * 64 + fr, col0 = u.pn * 256 + wc * 32 + 8 * fq;
#pragma unroll
        for (int ai = 0; ai < 2; ++ai)
#pragma unroll
            for (int m = 0; m < 4; ++m) { bf16_t* rowp = O + (size_t)(row0 + ai * 128 + m * 16) * ldc + col0;
#pragma unroll
                for (int bj = 0; bj < 2; ++bj) { const f32x4 v0 = acc[ai][bj][m][0], v1 = acc[ai][bj][m][1];
                    u32x4 w; w.x = pk2(v0[0], v0[1]); w.y = pk2(v0[2], v0[3]); w.z = pk2(v1[0], v1[1]); w.w = pk2(v1[2], v1[3]);
                    *(u32x4*)(rowp + bj * 128) = w; } }
    }
};
struct EpiSwi {
    static constexpr bool PERM = true;
    bf16_t* O;
    __device__ __forceinline__ void operator()(const f32x4 (&acc)[2][2][4][2], const pg8::Unit& u, int wr, int wc, int fr, int fq) const {
        const int row0 = u.pm * 256 + wr * 64 + fr, col0 = u.pn * 128 + wc * 32 + 8 * fq;
#pragma unroll
        for (int ai = 0; ai < 2; ++ai)
#pragma unroll
            for (int m = 0; m < 4; ++m) { bf16_t* rowp = O + (size_t)(row0 + ai * 128 + m * 16) * DFF + col0;
                float h[8];
#pragma unroll
                for (int n = 0; n < 2; ++n)
#pragma unroll
                    for (int j = 0; j < 4; ++j) h[n * 4 + j] = siluf_(acc[ai][0][m][n][j]) * acc[ai][1][m][n][j];
                *(u32x4*)rowp = pack8(h); }
    }
};
struct EpiRes {
    static constexpr bool PERM = false;
    const float* xin_l; const float* xin_c; float* xout_l; float* xout_c; const float* modl; int goff;
    __device__ __forceinline__ void operator()(const f32x4 (&acc)[2][2][4][2], const pg8::Unit& u, int wr, int wc, int fr, int fq) const {
        const int b = u.pm / 9, j = u.pm - 9 * b;
        const float* xi; float* xo; const float* gv;
        if (j == 0) { const size_t off = (size_t)b * CL * D; xi = xin_c + off; xo = xout_c + off; gv = modl + 32 * 6144 + goff; }
        else { const size_t off = ((size_t)b * TL + (size_t)(j - 1) * 256) * D; xi = xin_l + off; xo = xout_l + off; gv = modl + b * 6144 + goff; }
        const int rl0 = wr * 64 + fr, col0 = u.pn * 256 + wc * 32 + 4 * fq;
        f32x4 gate[2][2];
#pragma unroll
        for (int bj = 0; bj < 2; ++bj)
#pragma unroll
            for (int n = 0; n < 2; ++n) gate[bj][n] = *(const f32x4*)(gv + col0 + bj * 128 + n * 16);
#pragma unroll
        for (int ai = 0; ai < 2; ++ai)
#pragma unroll
            for (int m = 0; m < 4; ++m) { const size_t ro = (size_t)(rl0 + ai * 128 + m * 16) * D + col0;
#pragma unroll
                for (int bj = 0; bj < 2; ++bj)
#pragma unroll
                    for (int n = 0; n < 2; ++n) { const f32x4 xv = *(const f32x4*)(xi + ro + bj * 128 + n * 16);
                        *(f32x4*)(xo + ro + bj * 128 + n * 16) = xv + gate[bj][n] * acc[ai][bj][m][n]; } }
    }
};

__device__ __forceinline__ void convert_matrix(const float* W, int K, int N, int Np, int mode, bf16_t* Bt, float* sT) {
    const int ntiles = (Np >> 6) * (K >> 6);
    const int b0_ = bid_(), gd_ = gdim_();
    const int tid = tid_(), kr = tid >> 3, c8 = (tid & 7) * 8;
    const int nK = K >> 6;
    for (int t0 = b0_; t0 < ntiles; t0 += 4 * gd_) {
        float4 v0[4], v1[4]; int n0a[4], k0a[4];
#pragma unroll
        for (int u = 0; u < 4; ++u) { const int tile = t0 + u * gd_; v0[u] = (float4){0.f, 0.f, 0.f, 0.f}; v1[u] = v0[u]; n0a[u] = 0; k0a[u] = 0;
            if (tile < ntiles) { const int nt = tile / nK, kt = tile - nt * nK; const int n0 = nt * 64, k0 = kt * 64; n0a[u] = n0; k0a[u] = k0;
                int src0 = n0;
                if (mode == 1) { const int pn = n0 >> 8, rem = n0 & 255, half = rem >> 7, jj = rem & 127; src0 = half * DFF + pn * 128 + jj; }
                const float* src = W + (size_t)(k0 + kr) * N + src0 + c8;
                if (src0 + c8 < N) { v0[u] = *(const float4*)src; v1[u] = *(const float4*)(src + 4); } } }
#pragma unroll
        for (int u = 0; u < 4; ++u) { const int tile = t0 + u * gd_;
            if (tile < ntiles) {
                float* d = sT + kr * 65 + c8;
                d[0] = v0[u].x; d[1] = v0[u].y; d[2] = v0[u].z; d[3] = v0[u].w; d[4] = v1[u].x; d[5] = v1[u].y; d[6] = v1[u].z; d[7] = v1[u].w;
                __syncthreads();
                const int nr = tid >> 3, kg = (tid & 7) * 8;
                float o[8];
#pragma unroll
                for (int jj = 0; jj < 8; ++jj) o[jj] = sT[(kg + jj) * 65 + nr];
                *(u32x4*)(Bt + (size_t)(n0a[u] + nr) * K + k0a[u] + kg) = pack8(o);
                __syncthreads(); } }
    }
}
__device__ __forceinline__ void mod_item(const Params& p, int item, float* sS, float* sRed) {
    const int l = item / 48, cb = item - l * 48; const int tid = tid_(), c = tid & 127, kq = tid >> 7;
    const float* wm = inp(4) + (size_t)l * 1024 * 6144 + cb * 128 + c; const float* cvec = inp(1); const float* cctx = inp(3); const float* bmod = inp(5);
    float acc[33];
#pragma unroll
    for (int r = 0; r < 33; ++r) acc[r] = 0.f;
    for (int kc = 0; kc < 4; ++kc) {
        __syncthreads();
        for (int idx = tid; idx < 33 * 256; idx += 512) { const int r = idx >> 8, k = kc * 256 + (idx & 255);
            const float cv = (r < 32) ? cvec[r * 1024 + k] : cctx[k]; sS[idx] = siluf_(cv); }
        __syncthreads();
        for (int kk = 0; kk < 64; kk += 8) { const int kl = kq * 64 + kk; float w[8];
#pragma unroll
            for (int u = 0; u < 8; ++u) w[u] = wm[(size_t)(kc * 256 + kl + u) * 6144];
#pragma unroll
            for (int u = 0; u < 8; ++u)
#pragma unroll
                for (int r = 0; r < 33; ++r) acc[r] += sS[r * 256 + kl + u] * w[u]; }
    }
#pragma unroll
    for (int r = 0; r < 33; ++r) sRed[(kq * 33 + r) * 128 + c] = acc[r];
    __syncthreads();
    float* mod = (float*)(wsp() + OFF_MOD);
    for (int idx = tid; idx < 33 * 128; idx += 512) { const int r = idx >> 7, cc = idx & 127;
        float v = bmod[l * 6144 + cb * 128 + cc];
#pragma unroll
        for (int q = 0; q < 4; ++q) v += sRed[(q * 33 + r) * 128 + cc];
        mod[(size_t)(l * 33 + r) * 6144 + cb * 128 + cc] = v; }
    __syncthreads();
}

__device__ __forceinline__ void norm_phase(const float* xl, const float* xc, const float* g, const float* modl, int sh_off, int sc_off, bf16_t* H) {
    const int tid = tid_(), lane = tid & 63, gw = bid_() * 8 + (tid >> 6), nw = gdim_() * 8; const int a32 = x32addr_();
    for (int r4 = gw; r4 < MROWS / 4; r4 += nw) {
        const int row = r4 * 4; const int b = row / TT, t = row - b * TT;
        const float* src = (t < CL) ? xc + ((size_t)b * CL + t) * D : xl + ((size_t)b * TL + (t - CL)) * D;
        const float* mv = modl + (size_t)((t < CL) ? 32 : b) * 6144;
        f32x4 v[4][4];
#pragma unroll
        for (int rr = 0; rr < 4; ++rr)
#pragma unroll
            for (int i = 0; i < 4; ++i) v[rr][i] = __builtin_nontemporal_load((const f32x4*)(src + (size_t)rr * D + i * 256 + lane * 4));
        f32x4 mul[4], sh[4];
#pragma unroll
        for (int i = 0; i < 4; ++i) { const int c = i * 256 + lane * 4; mul[i] = *(const f32x4*)(g + c) * (*(const f32x4*)(mv + sc_off + c) + 1.0f); sh[i] = *(const f32x4*)(mv + sh_off + c); }
#pragma unroll
        for (int rr = 0; rr < 4; ++rr) {
            float ss = 0.f;
#pragma unroll
            for (int i = 0; i < 4; ++i) ss += v[rr][i][0] * v[rr][i][0] + v[rr][i][1] * v[rr][i][1] + v[rr][i][2] * v[rr][i][2] + v[rr][i][3] * v[rr][i][3];
            ss = red64(ss, a32);
            const float rs = rsqrtf(ss * (1.0f / 1024.0f) + 1e-6f);
#pragma unroll
            for (int i = 0; i < 4; ++i) { const f32x4 y = v[rr][i] * rs * mul[i] + sh[i];
                u32x2 w; w.x = pk2(y[0], y[1]); w.y = pk2(y[2], y[3]);
                *(u32x2*)(H + (size_t)(row + rr) * D + i * 256 + lane * 4) = w; }
        }
    }
}

__device__ __forceinline__ float shift3(float z, float pv, float nx, float m0, float m1) { return z + m0 * (pv - z) + m1 * (nx - z); }
__device__ __forceinline__ void even_feat_phase(const Params& p, int j, const bf16_t* Z, bf16_t* F, float* sm) {
    constexpr int WS = 104;
    const int tid = tid_(), lane = tid & 63, w = __builtin_amdgcn_readfirstlane(tid >> 6), q = lane & 15, g = lane >> 4;
    bf16_t* sLR = (bf16_t*)sm;
    bf16_t* sWT = sLR + 2 * 16 * WS;
    const float* mu = inp(15) + (size_t)j * 2 * 1728;
    const int b0_ = bid_(), gd_ = gdim_();
    int lj[3], ltk[3];
#pragma unroll
    for (int u = 0; u < 3; ++u) { const int idx = tid + 512 * u; lj[u] = idx >> 4; ltk[u] = idx & 15; }
    const int cb = 64 * w + q;
    {
        const float* wup = inp(17) + (size_t)j * 2 * 32 * 512;
        const float* aup = inp(19) + (size_t)j * 32 * 512;
        __syncthreads();
#pragma unroll 8
        for (int k = 0; k < 32; ++k) { sWT[tid * WS + k] = (bf16_t)f2bf(wup[k * 512 + tid]); sWT[tid * WS + 32 + k] = (bf16_t)f2bf(wup[(32 + k) * 512 + tid]); sWT[tid * WS + 64 + k] = (bf16_t)f2bf(aup[k * 512 + tid]); }
        __syncthreads();
        float w0f[4], w0b[4], a0c[4], kkc[4], kac[4], mr0[4], mr1[4], mk0[4], mk1[4], mv0[4], mv1[4];
#pragma unroll
        for (int ct = 0; ct < 4; ++ct) { const int c = cb + 16 * ct;
            w0f[ct] = inp(16)[(size_t)j * 1024 + c]; w0b[ct] = inp(16)[(size_t)j * 1024 + 512 + c]; a0c[ct] = inp(18)[(size_t)j * 512 + c]; kkc[ct] = inp(21)[j * 512 + c]; kac[ct] = inp(22)[j * 512 + c];
            mr0[ct] = mu[c]; mr1[ct] = mu[1728 + c]; mk0[ct] = mu[512 + c]; mk1[ct] = mu[1728 + 512 + c]; mv0[ct] = mu[1024 + c]; mv1[ct] = mu[1728 + 1024 + c]; }
        float ml0[3], ml1[3];
#pragma unroll
        for (int u = 0; u < 3; ++u) { ml0[u] = mu[1536 + lj[u]]; ml1[u] = mu[1728 + 1536 + lj[u]]; }
        for (int chunk = b0_; chunk < 256; chunk += gd_) {
            const int r0 = chunk * 144, t0 = (chunk & 15) * 144;
            bf16_t lw[3][3];
            auto load_group = [&](int gi) {
#pragma unroll
                for (int u = 0; u < 3; ++u) { const bf16_t* zl = Z + ((size_t)(r0 + 16 * gi + ltk[u]) * EV_INP + 1568 + 1536 + lj[u]) - EV_INP;
                    lw[u][0] = zl[0]; lw[u][1] = zl[EV_INP]; lw[u][2] = zl[2 * EV_INP]; }
            };
            load_group(0);
#pragma unroll 1
            for (int gi = 0; gi < 9; ++gi) {
                bf16_t* lr = sLR + (gi & 1) * 16 * WS;
#pragma unroll
                for (int u = 0; u < 3; ++u) { const int t = t0 + 16 * gi + ltk[u];
                    const bool hp = (t != 0) && (t != CL), hn = (t != CL - 1) && (t != TT - 1);
                    const float sl = shift3(bf1(lw[u][1]), hp ? bf1(lw[u][0]) : 0.f, hn ? bf1(lw[u][2]) : 0.f, ml0[u], ml1[u]);
                    lr[ltk[u] * WS + lj[u]] = (bf16_t)f2bf((lj[u] < 64) ? (2.0f * sigmoidf_(2.0f * sl) - 1.0f) : sl); }
                bf16_t zr_[4][6], zk_[4][6], zv_[4][6];
                { const bf16_t* zb = Z + ((size_t)(r0 + 16 * gi + 4 * g) * EV_INP + 1568 + cb) - EV_INP;
#pragma unroll
                  for (int i = 0; i < 6; ++i)
#pragma unroll
                      for (int ct = 0; ct < 4; ++ct) { const bf16_t* zz = zb + (size_t)i * EV_INP + 16 * ct; zr_[ct][i] = zz[0]; zk_[ct][i] = zz[512]; zv_[ct][i] = zz[1024]; } }
                if (gi + 1 < 9) load_group(gi + 1);
                __syncthreads();
                f32x4 Cf[4], Cb[4], Ca[4];
                { const bf16x8 A0 = *(const bf16x8*)(lr + q * WS + 8 * g), A1 = *(const bf16x8*)(lr + q * WS + 32 + 8 * g), A2 = *(const bf16x8*)(lr + q * WS + 64 + 8 * g);
                  const f32x4 z4 = {0.f, 0.f, 0.f, 0.f};
                  const LAS bf16_t* wq = (const LAS bf16_t*)sWT + (64 * w + q) * WS + 8 * g; asm volatile("" : "+v"(wq));
#pragma unroll
                  for (int ct = 0; ct < 4; ++ct) { const LAS bf16_t* wc = wq + 16 * ct * WS;
                      Cf[ct] = __builtin_amdgcn_mfma_f32_16x16x32_bf16(A0, *(const LAS bf16x8*)(wc), z4, 0, 0, 0); Cb[ct] = __builtin_amdgcn_mfma_f32_16x16x32_bf16(A1, *(const LAS bf16x8*)(wc + 32), z4, 0, 0, 0);
                      Ca[ct] = __builtin_amdgcn_mfma_f32_16x16x32_bf16(A2, *(const LAS bf16x8*)(wc + 64), z4, 0, 0, 0); } }
#pragma unroll
                for (int r = 0; r < 4; ++r) { const int t = t0 + 16 * gi + 4 * g + r;
                    const bool hp = (t != 0) && (t != CL), hn = (t != CL - 1) && (t != TT - 1);
                    float rs[4], ks[4], vs[4], kk[4], a[4], ss = 0.f;
#pragma unroll
                    for (int ct = 0; ct < 4; ++ct) {
                        rs[ct] = shift3(bf1(zr_[ct][r + 1]), hp ? bf1(zr_[ct][r]) : 0.f, hn ? bf1(zr_[ct][r + 2]) : 0.f, mr0[ct], mr1[ct]);
                        ks[ct] = shift3(bf1(zk_[ct][r + 1]), hp ? bf1(zk_[ct][r]) : 0.f, hn ? bf1(zk_[ct][r + 2]) : 0.f, mk0[ct], mk1[ct]);
                        vs[ct] = shift3(bf1(zv_[ct][r + 1]), hp ? bf1(zv_[ct][r]) : 0.f, hn ? bf1(zv_[ct][r + 2]) : 0.f, mv0[ct], mv1[ct]);
                        kk[ct] = ks[ct] * kkc[ct]; ss += kk[ct] * kk[ct]; a[ct] = sigmoidf_(Ca[ct][r] + a0c[ct]); }
                    const float rn = __builtin_amdgcn_rsqf(fmaxf(red16(ss), 1e-24f));
                    bf16_t* fo = F + (size_t)(r0 + 16 * gi + 4 * g + r) * 4096 + cb;
#pragma unroll
                    for (int ct = 0; ct < 4; ++ct) { const float kkn = kk[ct] * rn; bf16_t* f1 = fo + 16 * ct;
                        f1[0] = (bf16_t)f2bf(rs[ct]); f1[512] = (bf16_t)f2bf(ks[ct] * (1.0f + (a[ct] - 1.0f) * kac[ct])); f1[1024] = (bf16_t)f2bf(vs[ct]); f1[1536] = (bf16_t)f2bf(-kkn); f1[2048] = (bf16_t)f2bf(kkn * a[ct]);
                        f1[2560] = (bf16_t)f2bf(0.6065306597126334f * sigmoidf_(Cf[ct][r] + w0f[ct]));
                        f1[3072] = (bf16_t)f2bf(0.6065306597126334f * sigmoidf_(Cb[ct][r] + w0b[ct])); }
                }
            }
            __syncthreads();
        }
    }
    {
        const float* gup = inp(20) + (size_t)j * 96 * 512;
        __syncthreads();
#pragma unroll 8
        for (int k = 0; k < 96; ++k) sWT[tid * WS + k] = (bf16_t)f2bf(gup[k * 512 + tid]);
        __syncthreads();
        float ml0[3], ml1[3];
#pragma unroll
        for (int u = 0; u < 3; ++u) { ml0[u] = mu[1632 + lj[u]]; ml1[u] = mu[1728 + 1632 + lj[u]]; }
        for (int chunk = b0_; chunk < 256; chunk += gd_) {
            const int r0 = chunk * 144, t0 = (chunk & 15) * 144;
            bf16_t lw[3][3];
            auto load_group = [&](int gi) {
#pragma unroll
                for (int u = 0; u < 3; ++u) { const bf16_t* zl = Z + ((size_t)(r0 + 16 * gi + ltk[u]) * EV_INP + 1568 + 1632 + lj[u]) - EV_INP;
                    lw[u][0] = zl[0]; lw[u][1] = zl[EV_INP]; lw[u][2] = zl[2 * EV_INP]; }
            };
            load_group(0);
#pragma unroll 1
            for (int gi = 0; gi < 9; ++gi) {
                bf16_t* lr = sLR + (gi & 1) * 16 * WS;
#pragma unroll
                for (int u = 0; u < 3; ++u) { const int t = t0 + 16 * gi + ltk[u];
                    const bool hp = (t != 0) && (t != CL), hn = (t != CL - 1) && (t != TT - 1);
                    lr[ltk[u] * WS + lj[u]] = (bf16_t)f2bf(sigmoidf_(shift3(bf1(lw[u][1]), hp ? bf1(lw[u][0]) : 0.f, hn ? bf1(lw[u][2]) : 0.f, ml0[u], ml1[u]))); }
                if (gi + 1 < 9) load_group(gi + 1);
                __syncthreads();
                const bf16x8 A0 = *(const bf16x8*)(lr + q * WS + 8 * g), A1 = *(const bf16x8*)(lr + q * WS + 32 + 8 * g), A2 = *(const bf16x8*)(lr + q * WS + 64 + 8 * g);
                const LAS bf16_t* wq = (const LAS bf16_t*)sWT + (64 * w + q) * WS + 8 * g; asm volatile("" : "+v"(wq));
#pragma unroll
                for (int ct = 0; ct < 4; ++ct) { f32x4 c4 = {0.f, 0.f, 0.f, 0.f}; const LAS bf16_t* wc = wq + 16 * ct * WS;
                    c4 = __builtin_amdgcn_mfma_f32_16x16x32_bf16(A0, *(const LAS bf16x8*)(wc), c4, 0, 0, 0); c4 = __builtin_amdgcn_mfma_f32_16x16x32_bf16(A1, *(const LAS bf16x8*)(wc + 32), c4, 0, 0, 0); c4 = __builtin_amdgcn_mfma_f32_16x16x32_bf16(A2, *(const LAS bf16x8*)(wc + 64), c4, 0, 0, 0);
#pragma unroll
                    for (int r = 0; r < 4; ++r) F[(size_t)(r0 + 16 * gi + 4 * g + r) * 4096 + 3584 + cb + 16 * ct] = (bf16_t)f2bf(c4[r]); }
            }
            __syncthreads();
        }
    }
}

__device__ __forceinline__ int scan_tok(int s, int dir) { return dir == 0 ? s : (s < CL ? (CL - 1 - s) : (TT + CL - 1 - s)); }
__device__ __forceinline__ void rwkv_scan_phase(const bf16_t* F, bf16_t* O, float* sm) {
    const int tid = tid_(), rp = (tid >> 3) & 31, kg = tid & 7; const int b0_ = bid_(), gd_ = gdim_();
    float* sF = sm;
    float* sO = sm + 2 * 6 * 32 * 64;
    for (int item = b0_; item < 256; item += gd_) {
        const int bl = item >> 4, h = (item >> 1) & 7, dir = item & 1;
        const size_t rb = (size_t)bl * TT;
        f32x4 S[4] = {{0.f, 0.f, 0.f, 0.f}, {0.f, 0.f, 0.f, 0.f}, {0.f, 0.f, 0.f, 0.f}, {0.f, 0.f, 0.f, 0.f}};
        u32x4 pre[3];
        auto load_tile = [&](int tile) {
#pragma unroll
            for (int i = 0; i < 3; ++i) { const int q = tid + 512 * i, pair = q >> 3, part = q & 7, tokl = pair / 6, feat = pair - tokl * 6;
                const int tk = scan_tok(tile * 32 + tokl, dir);
                const int fo = (feat < 5) ? feat * 512 : (2560 + 512 * dir);
                pre[i] = *(const u32x4*)(F + (rb + tk) * 4096 + fo + h * 64 + part * 8); }
        };
        auto store_tile = [&](int buf) {
#pragma unroll
            for (int i = 0; i < 3; ++i) { const int q = tid + 512 * i, pair = q >> 3, part = q & 7, tokl = pair / 6, feat = pair - tokl * 6;
                float v[8]; unpack8(pre[i], v);
                if (feat == 5) {
#pragma unroll
                    for (int jx = 0; jx < 8; ++jx) v[jx] = __expf(-v[jx]); }
                float* d = sF + (((buf * 6 + feat) * 32 + tokl) * 64 + part * 8);
                *(f32x4*)d = (f32x4){v[0], v[1], v[2], v[3]}; *(f32x4*)(d + 4) = (f32x4){v[4], v[5], v[6], v[7]}; }
        };
        __syncthreads();
        load_tile(0); store_tile(0);
        __syncthreads();
        for (int tile = 0; tile < 72; ++tile) {
            const int buf = tile & 1;
            if (tile + 1 < 72) load_tile(tile + 1);
            const float* fb = sF + buf * 6 * 32 * 64;
            float* ob = sO + buf * 32 * 64;
#define RW_LOAD(P, off) { const float* fr_ = pa_ + (off); _Pragma("unroll") for (int e = 0; e < 2; ++e) { P##r[e] = *(const f32x4*)(fr_ + 4 * e); P##k[e] = *(const f32x4*)(fr_ + 2048 + 4 * e); \
                P##a[e] = *(const f32x4*)(fr_ + 3 * 2048 + 4 * e); P##b[e] = *(const f32x4*)(fr_ + 4 * 2048 + 4 * e); P##w[e] = *(const f32x4*)(fr_ + 5 * 2048 + 4 * e); } \
                P##v0 = pv_[(off)]; P##v1 = pv_[(off) + 1]; }
#define RW_STEP(P, off) { f32x4 ac0 = S[0] * P##a[0]; ac0 += S[1] * P##a[1]; f32x4 ac1 = S[2] * P##a[0]; ac1 += S[3] * P##a[1]; \
                const f32x2 pa0_ = __builtin_shufflevector(ac0, ac0, 0, 1) + __builtin_shufflevector(ac0, ac0, 2, 3), pa1_ = __builtin_shufflevector(ac1, ac1, 0, 1) + __builtin_shufflevector(ac1, ac1, 2, 3); \
                float sa0 = pa0_[0] + pa0_[1], sa1 = pa1_[0] + pa1_[1]; sa0 = red8(sa0); sa1 = red8(sa1); \
                S[0] = S[0] * P##w[0] + (sa0 * P##b[0] + P##v0 * P##k[0]); S[1] = S[1] * P##w[1] + (sa0 * P##b[1] + P##v0 * P##k[1]); \
                S[2] = S[2] * P##w[0] + (sa1 * P##b[0] + P##v1 * P##k[0]); S[3] = S[3] * P##w[1] + (sa1 * P##b[1] + P##v1 * P##k[1]); \
                f32x4 oc0 = S[0] * P##r[0]; oc0 += S[1] * P##r[1]; f32x4 oc1 = S[2] * P##r[0]; oc1 += S[3] * P##r[1]; \
                const f32x2 po0_ = __builtin_shufflevector(oc0, oc0, 0, 1) + __builtin_shufflevector(oc0, oc0, 2, 3), po1_ = __builtin_shufflevector(oc1, oc1, 0, 1) + __builtin_shufflevector(oc1, oc1, 2, 3); \
                float o0 = po0_[0] + po0_[1], o1 = po1_[0] + po1_[1]; { const float x0_ = o0 + dppf<0x141>(o0), x1_ = o1 + dppf<0x141>(o1); float x_ = hi4 ? x1_ : x0_; x_ += dppf<0xB1>(x_); x_ += dppf<0x4E>(x_); po_[(off)] = x_; } }
            const bool hi4 = (kg & 4) != 0;
            if (tid < 256) { f32x4 Ar[2], Ak[2], Aa[2], Ab[2], Aw[2], Br[2], Bk[2], Ba[2], Bb[2], Bw[2]; float Av0, Av1, Bv0, Bv1;
              const float* pa_ = fb + kg * 8; const float* pv_ = fb + 2 * 2048 + 2 * rp; float* po_ = ob + 2 * rp + (kg >> 2);
              RW_LOAD(A, 0)
#pragma unroll 1
              for (int i = 0; i < 32; i += 2) {
                  RW_LOAD(B, 64)
                  RW_STEP(A, 0)
                  RW_LOAD(A, 128)
                  RW_STEP(B, 64)
                  pa_ += 128; pv_ += 128; po_ += 128;
              } }
#undef RW_LOAD
#undef RW_STEP
            if (tile + 1 < 72) store_tile(buf ^ 1);
            __syncthreads();
            { const int tokl = tid >> 4, c4 = (tid & 15) * 4; const int tk = scan_tok(tile * 32 + tokl, dir);
              const f32x4 v = *(const f32x4*)(ob + tokl * 64 + c4);
              u32x2 w; w.x = pk2(v[0], v[1]); w.y = pk2(v[2], v[3]);
              *(u32x2*)(O + (rb + tk) * 2048 + 1024 + 512 * dir + h * 64 + c4) = w; }
        }
        __syncthreads();
    }
}

__device__ __forceinline__ void gla_phase(const Params& p, int j, const bf16_t* Z, bf16_t* O, float* sm) {
    constexpr int LS = 68, BS = 72;
    bf16_t* sQb = (bf16_t*)sm; bf16_t* sKb = sQb + 64 * BS; bf16_t* sKdT = sKb + 64 * BS; bf16_t* sVT = sKdT + 64 * BS; bf16_t* sAtt = sVT + 64 * BS; bf16_t* sST = sAtt + 64 * BS;
    float* sB = (float*)(sST + 64 * BS);
    float* sAup = sB + 64 * LS; float* sAd = sAup + 16 * 64; float* sSeg = sAd + 64 * 16; float* sTot = sSeg + 8 * 64;
    const int tid = tid_(), lane = tid & 63, wid = tid >> 6, q = lane & 15, g = lane >> 4; const int b0_ = bid_(), gd_ = gdim_();
    const int ti = wid >> 1, tc0 = (wid & 1) * 2;
    const int tok = tid >> 3, d0 = (tid & 7) * 8;
    for (int item = b0_; item < 256; item += gd_) {
        const int bl = item >> 4, h = (item >> 2) & 3, dir = (item >> 1) & 1, vh = item & 1;
        const size_t rb = (size_t)bl * TT;
        const float* aup = inp(12) + ((size_t)(j * 2 + dir) * 16) * 256 + h * 64;
        const float* abias = inp(13) + (size_t)(j * 2 + dir) * 256 + h * 64;
        __syncthreads();
        for (int idx = tid; idx < 64 * BS; idx += 512) sST[idx] = 0;
        float aupc[16]; const float biasc = abias[tid & 63];
#pragma unroll
        for (int i = 0; i < 16; ++i) aupc[i] = aup[i * 256 + (tid & 63)];
        f32x4 STa[2] = {{0.f, 0.f, 0.f, 0.f}, {0.f, 0.f, 0.f, 0.f}};
        u32x4 rq, rk, rv, ra;
        auto load_raw = [&](int ci) {
            const bf16_t* zr = Z + (rb + scan_tok(ci * 64 + tok, dir)) * EV_INP;
            rq = *(const u32x4*)(zr + h * 64 + d0); rk = *(const u32x4*)(zr + 256 + h * 64 + d0); rv = *(const u32x4*)(zr + 512 + h * 128 + vh * 64 + d0);
            const int t2 = (tid < 128) ? (tid >> 1) : 0;
            ra = *(const u32x4*)(Z + (rb + scan_tok(ci * 64 + t2, dir)) * EV_INP + 1536 + dir * 16 + (tid & 1) * 8);
        };
        load_raw(0);
        __syncthreads();
        for (int ci = 0; ci < 36; ++ci) {
            float q8[8], k8[8], v8[8];
            unpack8(rq, q8); unpack8(rk, k8); unpack8(rv, v8);
            if (tid < 128) { float a8[8]; unpack8(ra, a8);
                *(f32x4*)(sAd + (tid >> 1) * 16 + (tid & 1) * 8) = (f32x4){a8[0], a8[1], a8[2], a8[3]}; *(f32x4*)(sAd + (tid >> 1) * 16 + (tid & 1) * 8 + 4) = (f32x4){a8[4], a8[5], a8[6], a8[7]}; }
            __syncthreads();
            float loc[8];
            { const int dd = tid & 63, seg = tid >> 6; float run = 0.f;
#pragma unroll
              for (int i = 0; i < 8; ++i) { const float* ar = sAd + (seg * 8 + i) * 16;
                  const f32x4 a0 = *(const f32x4*)ar, a1 = *(const f32x4*)(ar + 4), a2 = *(const f32x4*)(ar + 8), a3 = *(const f32x4*)(ar + 12);
                  float x = biasc;
#pragma unroll
                  for (int e = 0; e < 4; ++e) { x += a0[e] * aupc[e]; x += a1[e] * aupc[4 + e]; x += a2[e] * aupc[8 + e]; x += a3[e] * aupc[12 + e]; }
                  run += (fminf(x, 0.f) - __logf(1.0f + __expf(-fabsf(x)))) * (1.0f / 16.0f); loc[i] = run; }
              sSeg[seg * 64 + dd] = run; }
            __syncthreads();
            { const int dd = tid & 63, seg = tid >> 6; float pre = 0.f;
              for (int s2 = 0; s2 < seg; ++s2) pre += sSeg[s2 * 64 + dd];
#pragma unroll
              for (int i = 0; i < 8; ++i) sB[(seg * 8 + i) * LS + dd] = loc[i] + pre; }
            __syncthreads();
            { float qb[8], kb[8];
#pragma unroll
              for (int i = 0; i < 8; ++i) { const float bb = sB[tok * LS + d0 + i], tot = sB[63 * LS + d0 + i];
                  qb[i] = q8[i] * 0.125f * __expf(bb); kb[i] = k8[i] * __expf(-bb);
                  sKdT[(d0 + i) * BS + tok] = (bf16_t)f2bf(k8[i] * __expf(tot - bb));
                  sVT[(d0 + i) * BS + tok] = (bf16_t)f2bf(v8[i]);
                  if (tok == 63) sTot[d0 + i] = tot; }
              *(u32x4*)(sQb + tok * BS + d0) = pack8(qb); *(u32x4*)(sKb + tok * BS + d0) = pack8(kb); }
            if (ci + 1 < 36) load_raw(ci + 1);
            __syncthreads();
            f32x4 oacc[2];
            { bf16x8 Aq[2];
#pragma unroll
              for (int ks = 0; ks < 2; ++ks) Aq[ks] = *(const bf16x8*)(sQb + (16 * ti + q) * BS + 32 * ks + 8 * g);
#pragma unroll
              for (int c = 0; c < 2; ++c) { const int tj = tc0 + c;
                  f32x4 at = {0.f, 0.f, 0.f, 0.f};
                  if (tj <= ti) {
#pragma unroll
                      for (int ks = 0; ks < 2; ++ks) { const bf16x8 Bk = *(const bf16x8*)(sKb + (16 * tj + q) * BS + 32 * ks + 8 * g); at = __builtin_amdgcn_mfma_f32_16x16x32_bf16(Aq[ks], Bk, at, 0, 0, 0); }
                      if (tj == ti) {
#pragma unroll
                          for (int r = 0; r < 4; ++r) if (q > 4 * g + r) at[r] = 0.f; } }
#pragma unroll
                  for (int r = 0; r < 4; ++r) sAtt[(16 * ti + 4 * g + r) * BS + 16 * tj + q] = (bf16_t)f2bf(at[r]);
                  f32x4 oc = {0.f, 0.f, 0.f, 0.f};
#pragma unroll
                  for (int ks = 0; ks < 2; ++ks) { const bf16x8 Bs = *(const bf16x8*)(sST + (16 * tj + q) * BS + 32 * ks + 8 * g); oc = __builtin_amdgcn_mfma_f32_16x16x32_bf16(Aq[ks], Bs, oc, 0, 0, 0); }
                  oacc[c] = oc; } }
            __syncthreads();
            { bf16x8 Aa[2], Av[2];
#pragma unroll
              for (int ks = 0; ks < 2; ++ks) { Aa[ks] = *(const bf16x8*)(sAtt + (16 * ti + q) * BS + 32 * ks + 8 * g); Av[ks] = *(const bf16x8*)(sVT + (16 * ti + q) * BS + 32 * ks + 8 * g); }
#pragma unroll
              for (int c = 0; c < 2; ++c) { const int tv = tc0 + c;
                  f32x4 oc = oacc[c];
#pragma unroll
                  for (int ks = 0; ks < 2; ++ks) { const bf16x8 Bv = *(const bf16x8*)(sVT + (16 * tv + q) * BS + 32 * ks + 8 * g); oc = __builtin_amdgcn_mfma_f32_16x16x32_bf16(Aa[ks], Bv, oc, 0, 0, 0); }
#pragma unroll
                  for (int r = 0; r < 4; ++r) { const int tk = scan_tok(ci * 64 + 16 * ti + 4 * g + r, dir);
                      O[(rb + tk) * 2048 + 512 * dir + h * 128 + vh * 64 + 16 * tv + q] = (bf16_t)f2bf(oc[r]); }
                  const float et = __expf(sTot[16 * tv + q]);
                  f32x4 st = STa[c] * et;
#pragma unroll
                  for (int ks = 0; ks < 2; ++ks) { const bf16x8 Bkd = *(const bf16x8*)(sKdT + (16 * tv + q) * BS + 32 * ks + 8 * g); st = __builtin_amdgcn_mfma_f32_16x16x32_bf16(Av[ks], Bkd, st, 0, 0, 0); }
                  STa[c] = st;
#pragma unroll
                  for (int r = 0; r < 4; ++r) sST[(16 * ti + 4 * g + r) * BS + 16 * tv + q] = (bf16_t)f2bf(st[r]); } }
            __syncthreads();
        }
    }
}

__device__ __forceinline__ void even_merge_phase(const Params& p, int j, const bf16_t* Z, const bf16_t* F, const bf16_t* O, bf16_t* Y) {
    const int tid = tid_(), lane = tid & 63, gw = bid_() * 8 + (tid >> 6), nw = gdim_() * 8;
    const int c8 = lane * 8;
    const float* pgg = inp(14); const float* plg = inp(24); const float* plb = inp(25); const float* prk = inp(23);
    float gg[8], lg[8], lb[8], rk[8];
#pragma unroll
    for (int i = 0; i < 8; ++i) { gg[i] = pgg[j * 128 + ((c8 + i) & 127)]; lg[i] = plg[j * 512 + c8 + i]; lb[i] = plb[j * 512 + c8 + i]; rk[i] = prk[j * 512 + c8 + i]; }
    for (int zl0 = gw * 2; zl0 < HROWS; zl0 += nw * 2) {
        u32x4 L[2][9];
#pragma unroll
        for (int tt = 0; tt < 2; ++tt) { const int zl = zl0 + tt;
            const bf16_t* orow = O + (size_t)zl * 2048; const bf16_t* zrow = Z + (size_t)zl * EV_INP; const bf16_t* frow = F + (size_t)zl * 4096;
            L[tt][0] = __builtin_nontemporal_load((const u32x4*)(orow + c8)); L[tt][1] = __builtin_nontemporal_load((const u32x4*)(orow + 512 + c8)); L[tt][2] = __builtin_nontemporal_load((const u32x4*)(zrow + 1024 + c8));
            L[tt][3] = __builtin_nontemporal_load((const u32x4*)(orow + 1024 + c8)); L[tt][4] = __builtin_nontemporal_load((const u32x4*)(orow + 1536 + c8));
            L[tt][5] = __builtin_nontemporal_load((const u32x4*)(frow + c8)); L[tt][6] = __builtin_nontemporal_load((const u32x4*)(frow + 512 + c8)); L[tt][7] = __builtin_nontemporal_load((const u32x4*)(frow + 1024 + c8)); L[tt][8] = __builtin_nontemporal_load((const u32x4*)(frow + 3584 + c8)); }
#pragma unroll
        for (int tt = 0; tt < 2; ++tt) { const int zl = zl0 + tt;
            float a[8], b[8], y[8];
            unpack8(L[tt][0], a); unpack8(L[tt][1], b);
            float ss = 0.f;
#pragma unroll
            for (int i = 0; i < 8; ++i) { a[i] += b[i]; ss += a[i] * a[i]; }
            ss = red16(ss);
            const float rs = rsqrtf(ss * (1.0f / 128.0f) + 1e-6f);
            unpack8(L[tt][2], b);
#pragma unroll
            for (int i = 0; i < 8; ++i) y[i] = a[i] * rs * gg[i] * siluf_(b[i]);
            *(u32x4*)(Y + (size_t)zl * D + c8) = pack8(y);
            unpack8(L[tt][3], a); unpack8(L[tt][4], b);
            float sm_ = 0.f;
#pragma unroll
            for (int i = 0; i < 8; ++i) { a[i] += b[i]; sm_ += a[i]; }
            const float mean = red8(sm_) * (1.0f / 64.0f);
            float sv = 0.f;
#pragma unroll
            for (int i = 0; i < 8; ++i) { a[i] -= mean; sv += a[i] * a[i]; }
            const float rstd = rsqrtf(red8(sv) * (1.0f / 64.0f) + 64e-5f);
            float r8[8], k8[8], v8[8], g8[8];
            unpack8(L[tt][5], r8); unpack8(L[tt][6], k8); unpack8(L[tt][7], v8); unpack8(L[tt][8], g8);
            float bs = 0.f;
#pragma unroll
            for (int i = 0; i < 8; ++i) bs += r8[i] * k8[i] * rk[i];
            bs = red8(bs);
#pragma unroll
            for (int i = 0; i < 8; ++i) y[i] = (a[i] * rstd * lg[i] + lb[i] + bs * v8[i]) * g8[i];
            *(u32x4*)(Y + (size_t)zl * D + 512 + c8) = pack8(y);
        }
    }
}

__device__ __forceinline__ void odd_feat_phase(const Params& p, int j, bf16_t* Z, bf16_t* VTG, bf16_t* VTN, float* sm) {
    const int tid = tid_(), lane = tid & 63, wid = tid >> 6; const int b0_ = bid_(), gd_ = gdim_();
    bf16_t* sVT = (bf16_t*)sm;
    const int c8 = lane * 8, d0 = (lane & 7) * 8;
    const float* pqg = inp(28); const float* pkg = inp(29);
    float qg[8], kg_[8], inv[8];
#pragma unroll
    for (int i = 0; i < 8; ++i) { qg[i] = pqg[j * 64 + d0 + i]; kg_[i] = pkg[j * 64 + d0 + i]; inv[i] = exp2f(-(float)((d0 & 15) + i) * (13.287712379549449f / 16.0f)); }
    const int ax = d0 >> 5, pp = (d0 >> 4) & 1;
    for (int tile = b0_; tile < MROWS / 64; tile += gd_) {
        const int row0 = tile * 64; const int b = row0 / TT, t0 = row0 - b * TT;
        const bool lat = t0 >= CL;
        for (int i8 = 0; i8 < 8; ++i8) {
            const int tokl = wid * 8 + i8; const int t = t0 + tokl;
            bf16_t* zr = Z + (size_t)(row0 + tokl) * OD_IN;
            const u32x4 wq = *(const u32x4*)(zr + c8), wk = *(const u32x4*)(zr + 512 + (c8 & 127)), wvc = *(const u32x4*)(zr + 640 + (c8 & 127)), wqd = *(const u32x4*)(zr + 768 + c8), wvd = *(const u32x4*)(zr + 1792 + c8);
            const int tl = t - CL;
            const float pos = (float)(ax == 0 ? (tl >> 6) : (tl & 63));
            float cs[8], sn[8];
            if (lat) {
#pragma unroll
                for (int i = 0; i < 8; ++i) { const float ang = pos * inv[i]; cs[i] = __cosf(ang); sn[i] = __sinf(ang); } }
            float x[8], xp[8];
            unpack8(wq, x);
            { float ss = 0.f;
#pragma unroll
              for (int i = 0; i < 8; ++i) ss += x[i] * x[i];
              const float rs = rsqrtf(red8(ss) * (1.0f / 64.0f) + 1e-6f);
#pragma unroll
              for (int i = 0; i < 8; ++i) x[i] = x[i] * rs * qg[i]; }
            if (lat) {
#pragma unroll
                for (int i = 0; i < 8; ++i) { xp[i] = shx2(x[i]); }
#pragma unroll
                for (int i = 0; i < 8; ++i) x[i] = (pp == 0) ? (x[i] * cs[i] - xp[i] * sn[i]) : (xp[i] * sn[i] + x[i] * cs[i]); }
#pragma unroll
            for (int i = 0; i < 8; ++i) x[i] *= 0.18033688011112042f;
            *(u32x4*)(zr + c8) = pack8(x);
            float kx[8];
            unpack8(wk, kx);
            { float ss = 0.f;
#pragma unroll
              for (int i = 0; i < 8; ++i) ss += kx[i] * kx[i];
              const float rs = rsqrtf(red8(ss) * (1.0f / 64.0f) + 1e-6f);
#pragma unroll
              for (int i = 0; i < 8; ++i) kx[i] = kx[i] * rs * kg_[i]; }
            if (lat) {
#pragma unroll
                for (int i = 0; i < 8; ++i) { xp[i] = shx2(kx[i]); }
#pragma unroll
                for (int i = 0; i < 8; ++i) kx[i] = (pp == 0) ? (kx[i] * cs[i] - xp[i] * sn[i]) : (xp[i] * sn[i] + kx[i] * cs[i]); }
            if (lane < 16) {
                *(u32x4*)(zr + 512 + c8) = pack8(kx);
                bf16_t* vt = sVT + (size_t)c8 * 72 + tokl;
                vt[0] = (bf16_t)(wvc.x & 0xffff); vt[72] = (bf16_t)(wvc.x >> 16); vt[2 * 72] = (bf16_t)(wvc.y & 0xffff); vt[3 * 72] = (bf16_t)(wvc.y >> 16);
                vt[4 * 72] = (bf16_t)(wvc.z & 0xffff); vt[5 * 72] = (bf16_t)(wvc.z >> 16); vt[6 * 72] = (bf16_t)(wvc.w & 0xffff); vt[7 * 72] = (bf16_t)(wvc.w >> 16);
            }
            unpack8(wqd, x);
#pragma unroll
            for (int i = 0; i < 8; ++i) x[i] *= 0.18033688011112042f;
            *(u32x4*)(zr + 768 + c8) = pack8(x);
            { bf16_t* vt = sVT + (size_t)(128 + c8) * 72 + tokl;
              vt[0] = (bf16_t)(wvd.x & 0xffff); vt[72] = (bf16_t)(wvd.x >> 16); vt[2 * 72] = (bf16_t)(wvd.y & 0xffff); vt[3 * 72] = (bf16_t)(wvd.y >> 16);
              vt[4 * 72] = (bf16_t)(wvd.z & 0xffff); vt[5 * 72] = (bf16_t)(wvd.z >> 16); vt[6 * 72] = (bf16_t)(wvd.w & 0xffff); vt[7 * 72] = (bf16_t)(wvd.w >> 16); }
        }
        __syncthreads();
#pragma unroll
        for (int i = 0; i < 10; ++i) { const int id = tid + 512 * i, row = id >> 3, part = id & 7;
            const u32x4 w = *(const u32x4*)(sVT + row * 72 + part * 8);
            bf16_t* dst = (row < 128) ? VTG + ((size_t)(b * 2) * 64 + row) * TT : VTN + ((size_t)(b * 8) * 64 + (row - 128)) * TT;
            *(u32x4*)(dst + t0 + part * 8) = w; }
        __syncthreads();
    }
}

struct AttnTask { const bf16_t* Q; const bf16_t* Kd; const bf16_t* VTd; int nd; const bf16_t* Kn; const bf16_t* VTn; int nb; int r; int qc0; const float* rpb; bf16_t* Y; };
__device__ __forceinline__ void attn_load(const bf16_t* Kp, const bf16_t* VTp, bf16x8 (&Kf)[2][2], bf16x8 (&Vf)[4], int q, int g) {
#pragma unroll
    for (int kt = 0; kt < 2; ++kt)
#pragma unroll
        for (int ks = 0; ks < 2; ++ks) Kf[kt][ks] = *(const bf16x8*)(Kp + (size_t)(16 * kt + q) * OD_IN + 32 * ks + 8 * g);
#pragma unroll
    for (int dt = 0; dt < 4; ++dt) { const bf16_t* vp = VTp + (size_t)(16 * dt + q) * TT + 4 * g;
        const u32x2 lo = *(const u32x2*)vp, hi = *(const u32x2*)(vp + 16);
        u32x4 w; w.x = lo.x; w.y = lo.y; w.z = hi.x; w.w = hi.y; Vf[dt] = __builtin_bit_cast(bf16x8, w); }
}
__device__ __forceinline__ void attn_compute(const bf16x8 (&Kf)[2][2], const bf16x8 (&Vf)[4], const bf16x8 (&Qf)[2][2], f32x4 (&Oa)[2][4], float (&mrun)[2], float (&lrun)[2], int q, int g, bool nbr, int qc0, int cb, const float* brow, int a32) {
#pragma unroll
    for (int qt = 0; qt < 2; ++qt) {
        if (nbr && ((qc0 + 16 * qt == 0 && cb == 32) || (qc0 + 16 * qt == 48 && cb == 0))) continue;
        f32x4 S0 = {0.f, 0.f, 0.f, 0.f}, S1 = {0.f, 0.f, 0.f, 0.f};
#pragma unroll
        for (int ks = 0; ks < 2; ++ks) { S0 = __builtin_amdgcn_mfma_f32_16x16x32_bf16(Kf[0][ks], Qf[qt][ks], S0, 0, 0, 0); S1 = __builtin_amdgcn_mfma_f32_16x16x32_bf16(Kf[1][ks], Qf[qt][ks], S1, 0, 0, 0); }
        if (nbr) {
            const int c = qc0 + 16 * qt + q; int st = c - 8; st = st < 0 ? 0 : (st > 48 ? 48 : st);
#pragma unroll
            for (int i = 0; i < 4; ++i) { const int cw0 = cb + 4 * g + i, cw1 = cw0 + 16;
                S0[i] = (cw0 >= st && cw0 < st + 16) ? S0[i] + brow[cw0 - c + 15] : -200.f;
                S1[i] = (cw1 >= st && cw1 < st + 16) ? S1[i] + brow[cw1 - c + 15] : -200.f; }
        }
        float pv[8]; float ps = 0.f;
#pragma unroll
        for (int i = 0; i < 4; ++i) { pv[i] = __builtin_amdgcn_exp2f(fminf(S0[i], 80.f)); pv[4 + i] = __builtin_amdgcn_exp2f(fminf(S1[i], 80.f)); ps += pv[i] + pv[4 + i]; }
        lrun[qt] += ps;
        const bf16x8 Pq = __builtin_bit_cast(bf16x8, pack8(pv));
#pragma unroll
        for (int dt = 0; dt < 4; ++dt) Oa[qt][dt] = __builtin_amdgcn_mfma_f32_16x16x32_bf16(Vf[dt], Pq, Oa[qt][dt], 0, 0, 0);
    }
}
__device__ __forceinline__ void attn_wave(const AttnTask& t, int lane, int a32) {
    const int q = lane & 15, g = lane >> 4;
    bf16x8 Qf[2][2];
#pragma unroll
    for (int qt = 0; qt < 2; ++qt)
#pragma unroll
        for (int ks = 0; ks < 2; ++ks) Qf[qt][ks] = *(const bf16x8*)(t.Q + (size_t)(16 * qt + q) * OD_IN + 32 * ks + 8 * g);
    f32x4 Oa[2][4];
#pragma unroll
    for (int qt = 0; qt < 2; ++qt)
#pragma unroll
        for (int dt = 0; dt < 4; ++dt) Oa[qt][dt] = (f32x4){0.f, 0.f, 0.f, 0.f};
    float mrun[2] = {-1e30f, -1e30f}, lrun[2] = {0.f, 0.f};
    const int nds = t.nd >> 5, nsteps = nds + (t.nb == 1 ? 16 : 0);
    int rs = t.r - 4; rs = rs < 0 ? 0 : (rs > 24 ? 24 : rs);
    auto srcK = [&](int s) -> const bf16_t* { if (s < nds) return t.Kd + (size_t)s * 32 * OD_IN; const int u = s - nds; return t.Kn + (size_t)((rs + (u >> 1)) * 64 + (u & 1) * 32) * OD_IN; };
    auto srcV = [&](int s) -> const bf16_t* { if (s < nds) return t.VTd + s * 32; const int u = s - nds; return t.VTn + ((rs + (u >> 1)) * 64 + (u & 1) * 32); };
    bf16x8 KA[2][2], VA[4], KB[2][2], VB[4];
    attn_load(srcK(0), srcV(0), KA, VA, q, g);
    for (int s = 0; s < nsteps; s += 2) {
        attn_load(srcK(s + 1), srcV(s + 1), KB, VB, q, g);
        { const bool nbr = s >= nds; const int u = s - nds;
          attn_compute(KA, VA, Qf, Oa, mrun, lrun, q, g, nbr, t.qc0, (u & 1) * 32, t.rpb + (rs + (u >> 1) - t.r + 7) * 31, a32); }
        if (s + 2 < nsteps) attn_load(srcK(s + 2), srcV(s + 2), KA, VA, q, g);
        { const bool nbr = s + 1 >= nds; const int u = s + 1 - nds;
          attn_compute(KB, VB, Qf, Oa, mrun, lrun, q, g, nbr, t.qc0, (u & 1) * 32, t.rpb + (rs + (u >> 1) - t.r + 7) * 31, a32); }
    }
#pragma unroll
    for (int qt = 0; qt < 2; ++qt) {
        float l = lrun[qt]; l += shx16(l); l += shx32(l, a32);
        const float inv = 1.0f / l;
#pragma unroll
        for (int dt = 0; dt < 4; ++dt) { const f32x4 o = Oa[qt][dt] * inv; u32x2 w; w.x = pk2(o[0], o[1]); w.y = pk2(o[2], o[3]);
            *(u32x2*)(t.Y + (size_t)(16 * qt + q) * D + 16 * dt + 4 * g) = w; }
    }
}
__device__ __forceinline__ void gqa_block(const bf16_t* Qw, const bf16_t* Kd, const bf16_t* VTd, int nd, bf16_t* Yw, bf16_t* sKV, int tid, int lane, int a32) {
    const int q = lane & 15, g = lane >> 4;
    bf16x8 Qf[2][2];
#pragma unroll
    for (int qt = 0; qt < 2; ++qt)
#pragma unroll
        for (int ks = 0; ks < 2; ++ks) Qf[qt][ks] = *(const bf16x8*)(Qw + (size_t)(16 * qt + q) * OD_IN + 32 * ks + 8 * g);
    f32x4 Oa[2][4];
#pragma unroll
    for (int qt = 0; qt < 2; ++qt)
#pragma unroll
        for (int dt = 0; dt < 4; ++dt) Oa[qt][dt] = (f32x4){0.f, 0.f, 0.f, 0.f};
    float mrun[2] = {-1e30f, -1e30f}, lrun[2] = {0.f, 0.f};
    const int ntiles = nd >> 6;
    const int srow = tid >> 3, sch = (tid & 7) * 8;
    const bf16_t* kg_ = Kd + (size_t)srow * OD_IN + sch; const bf16_t* vg_ = VTd + (size_t)srow * TT + sch;
    bf16_t* sK = sKV; bf16_t* sV = sKV + 2 * 64 * 72;
    u32x4 pkA = *(const u32x4*)kg_, pvA = *(const u32x4*)vg_;
    u32x4 pkB = *(const u32x4*)(kg_ + (size_t)64 * OD_IN), pvB = *(const u32x4*)(vg_ + 64);
    __syncthreads();
    *(u32x4*)(sK + srow * 72 + sch) = pkA; *(u32x4*)(sV + srow * 72 + sch) = pvA;
    if (2 < ntiles) { pkA = *(const u32x4*)(kg_ + (size_t)2 * 64 * OD_IN); pvA = *(const u32x4*)(vg_ + 2 * 64); }
    __syncthreads();
    auto compute_tile = [&](int buf) {
        const bf16_t* bK = sK + buf * 64 * 72; const bf16_t* bV = sV + buf * 64 * 72;
#pragma unroll
        for (int ss = 0; ss < 2; ++ss) {
            bf16x8 Kf[2][2], Vf[4];
#pragma unroll
            for (int kt = 0; kt < 2; ++kt)
#pragma unroll
                for (int ks = 0; ks < 2; ++ks) Kf[kt][ks] = *(const bf16x8*)(bK + (32 * ss + 16 * kt + q) * 72 + 32 * ks + 8 * g);
#pragma unroll
            for (int dt = 0; dt < 4; ++dt) { const bf16_t* vp = bV + (16 * dt + q) * 72 + 32 * ss + 4 * g;
                const u32x2 lo = *(const u32x2*)vp, hi = *(const u32x2*)(vp + 16);
                u32x4 w; w.x = lo.x; w.y = lo.y; w.z = hi.x; w.w = hi.y; Vf[dt] = __builtin_bit_cast(bf16x8, w); }
            attn_compute(Kf, Vf, Qf, Oa, mrun, lrun, q, g, false, 0, 0, nullptr, a32);
        }
    };
    for (int i = 0; i < ntiles; i += 2) {
        compute_tile(0);
        *(u32x4*)(sK + 64 * 72 + srow * 72 + sch) = pkB; *(u32x4*)(sV + 64 * 72 + srow * 72 + sch) = pvB;
        if (i + 3 < ntiles) { pkB = *(const u32x4*)(kg_ + (size_t)(i + 3) * 64 * OD_IN); pvB = *(const u32x4*)(vg_ + (i + 3) * 64); }
        __syncthreads();
        compute_tile(1);
        if (i + 2 < ntiles) { *(u32x4*)(sK + srow * 72 + sch) = pkA; *(u32x4*)(sV + srow * 72 + sch) = pvA; }
        if (i + 4 < ntiles) { pkA = *(const u32x4*)(kg_ + (size_t)(i + 4) * 64 * OD_IN); pvA = *(const u32x4*)(vg_ + (i + 4) * 64); }
        __syncthreads();
    }
#pragma unroll
    for (int qt = 0; qt < 2; ++qt) {
        float l = lrun[qt]; l += shx16(l); l += shx32(l, a32);
        const float inv = 1.0f / l;
#pragma unroll
        for (int dt = 0; dt < 4; ++dt) { const f32x4 o = Oa[qt][dt] * inv; u32x2 w; w.x = pk2(o[0], o[1]); w.y = pk2(o[2], o[3]);
            *(u32x2*)(Yw + (size_t)(16 * qt + q) * D + 16 * dt + 4 * g) = w; }
    }
}
__device__ __forceinline__ void na_block(const bf16_t* Qw, const bf16_t* Kb, const bf16_t* VTb, int r, int hw, int qc0, const float* rpbh, bf16_t* Yw, bf16_t* sKV, int tid, int lane, int a32) {
    const int q = lane & 15, g = lane >> 4;
    bf16x8 Qf[2][2];
#pragma unroll
    for (int qt = 0; qt < 2; ++qt)
#pragma unroll
        for (int ks = 0; ks < 2; ++ks) Qf[qt][ks] = *(const bf16x8*)(Qw + (size_t)(16 * qt + q) * OD_IN + 32 * ks + 8 * g);
    f32x4 Oa[2][4];
#pragma unroll
    for (int qt = 0; qt < 2; ++qt)
#pragma unroll
        for (int dt = 0; dt < 4; ++dt) Oa[qt][dt] = (f32x4){0.f, 0.f, 0.f, 0.f};
    float mrun[2] = {0.f, 0.f}, lrun[2] = {0.f, 0.f};
    int rs = r - 4; rs = rs < 0 ? 0 : (rs > 24 ? 24 : rs);
    const int kh0 = tid >> 8, krow = (tid >> 3) & 31, kpart = (tid & 7) * 8;
    const int vrow = (tid >> 2) & 63, vpart = (tid & 3) * 8;
    const bf16_t* kg0 = Kb + (size_t)krow * OD_IN + kh0 * 64 + kpart; const bf16_t* vg0 = VTb + ((size_t)kh0 * 64 + vrow) * TT + vpart;
    bf16_t* sK = sKV; bf16_t* sV = sKV + 2 * 4 * 32 * 72;
    const int skoff = (kh0 * 32 + krow) * 72 + kpart, svoff = (kh0 * 64 + vrow) * 40 + vpart;
    auto koff = [&](int s) -> int { return s < 8 ? 32 * s : CL + (rs + ((s - 8) >> 1)) * 64 + ((s - 8) & 1) * 32; };
#define NA_LOAD(P, s) { const int ko_ = koff(s); P##k0 = *(const u32x4*)(kg0 + (size_t)ko_ * OD_IN); P##k1 = *(const u32x4*)(kg0 + (size_t)ko_ * OD_IN + 128); P##v0 = *(const u32x4*)(vg0 + ko_); P##v1 = *(const u32x4*)(vg0 + (size_t)128 * TT + ko_); }
#define NA_STORE(P, buf) { *(u32x4*)(sK + (buf) * 4 * 32 * 72 + skoff) = P##k0; *(u32x4*)(sK + (buf) * 4 * 32 * 72 + skoff + 2 * 32 * 72) = P##k1; \
        *(u32x4*)(sV + (buf) * 4 * 64 * 40 + svoff) = P##v0; *(u32x4*)(sV + (buf) * 4 * 64 * 40 + svoff + 2 * 64 * 40) = P##v1; }
    u32x4 Ak0, Ak1, Av0, Av1;
    NA_LOAD(A, 0)
    __syncthreads();
    NA_STORE(A, 0)
    NA_LOAD(A, 1)
    __syncthreads();
    auto compute_step = [&](int buf, int s) {
        const bf16_t* bK = sK + (buf * 4 + hw) * 32 * 72; const bf16_t* bV = sV + (buf * 4 + hw) * 64 * 40;
        bf16x8 Kf[2][2], Vf[4];
#pragma unroll
        for (int kt = 0; kt < 2; ++kt)
#pragma unroll
            for (int ks = 0; ks < 2; ++ks) Kf[kt][ks] = *(const bf16x8*)(bK + (16 * kt + q) * 72 + 32 * ks + 8 * g);
#pragma unroll
        for (int dt = 0; dt < 4; ++dt) { const bf16_t* vp = bV + (16 * dt + q) * 40 + 4 * g;
            const u32x2 lo = *(const u32x2*)vp, hi = *(const u32x2*)(vp + 16);
            u32x4 w; w.x = lo.x; w.y = lo.y; w.z = hi.x; w.w = hi.y; Vf[dt] = __builtin_bit_cast(bf16x8, w); }
        const int u = s - 8;
        attn_compute(Kf, Vf, Qf, Oa, mrun, lrun, q, g, s >= 8, qc0, (u & 1) * 32, rpbh + (rs + (u >> 1) - r + 7) * 31, a32);
    };
#pragma unroll 1
    for (int s = 0; s < 24; ++s) {
        const int buf = s & 1;
        compute_step(buf, s);
        if (s + 1 < 24) NA_STORE(A, buf ^ 1)
        if (s + 2 < 24) NA_LOAD(A, s + 2)
        __syncthreads();
    }
#undef NA_LOAD
#undef NA_STORE
#pragma unroll
    for (int qt = 0; qt < 2; ++qt) {
        float l = lrun[qt]; l += shx16(l); l += shx32(l, a32);
        const float inv = 1.0f / l;
#pragma unroll
        for (int dt = 0; dt < 4; ++dt) { const f32x4 o = Oa[qt][dt] * inv; u32x2 w; w.x = pk2(o[0], o[1]); w.y = pk2(o[2], o[3]);
            *(u32x2*)(Yw + (size_t)(16 * qt + q) * D + 16 * dt + 4 * g) = w; }
    }
}
__device__ __forceinline__ void odd_attn_phase(const Params& p, int j, bool need_ctx, const bf16_t* Z, const bf16_t* VTG, const bf16_t* VTN, bf16_t* Y, float* sRpb) {
    const int tid = tid_(), wid = __builtin_amdgcn_readfirstlane(tid >> 6), lane = tid & 63; const int b0_ = bid_(), gd_ = gdim_(); const int a32 = x32addr_();
    __syncthreads();
    { const float* prpb = inp(30) + (size_t)j * 8 * 465; for (int idx = tid; idx < 8 * 465; idx += 512) sRpb[idx] = prpb[idx] * 1.4426950408889634f; }
    __syncthreads();
    const int ntask = 4096 + (need_ctx ? 512 : 0);
    for (int task = b0_; task < ntask; task += gd_) {
        AttnTask t; t.nb = 0; t.Kn = nullptr; t.VTn = nullptr; t.r = 0; t.qc0 = 0; t.rpb = sRpb;
        if (task < 2048) {
            const int b = task >> 6, kvh = (task >> 5) & 1, qb = task & 31, hq = kvh * 4 + (wid >> 1), qh = wid & 1;
            const size_t row = (size_t)b * TT + CL + qb * 64 + qh * 32;
            t.Q = Z + row * OD_IN + hq * 64; t.Kd = Z + (size_t)b * TT * OD_IN + 512 + kvh * 64; t.VTd = VTG + (size_t)(b * 2 + kvh) * 64 * TT; t.nd = TT;
            t.Y = Y + row * D + hq * 64; t.nb = 2;
        } else if (task < 4096) {
            const int tk = task - 2048; const int b = tk >> 6, r = (tk >> 1) & 31, h = (tk & 1) * 4 + (wid >> 1), qh = wid & 1;
            const size_t row = (size_t)b * TT + CL + r * 64 + qh * 32;
            t.Q = Z + row * OD_IN + 768 + h * 64; t.Kd = Z + (size_t)b * TT * OD_IN + 1280 + h * 64; t.VTd = VTN + (size_t)(b * 8 + h) * 64 * TT; t.nd = CL;
            t.Kn = t.Kd + (size_t)CL * OD_IN; t.VTn = t.VTd + CL; t.nb = 1; t.r = r; t.qc0 = qh * 32; t.rpb = sRpb + h * 465;
            t.Y = Y + row * D + 512 + h * 64;
        } else if (task < 4352) {
            const int tk = task - 4096; const int b = tk >> 3, kvh = (tk >> 2) & 1, qb = tk & 3, hq = kvh * 4 + (wid >> 1), qh = wid & 1;
            const size_t row = (size_t)b * TT + qb * 64 + qh * 32;
            t.Q = Z + row * OD_IN + hq * 64; t.Kd = Z + (size_t)b * TT * OD_IN + 512 + kvh * 64; t.VTd = VTG + (size_t)(b * 2 + kvh) * 64 * TT; t.nd = CL;
            t.Y = Y + row * D + hq * 64; t.nb = 2;
        } else {
            const int tk = task - 4352; const int b = tk >> 3, qblk = tk & 7, h = wid;
            const size_t row = (size_t)b * TT + qblk * 32;
            t.Q = Z + row * OD_IN + 768 + h * 64; t.Kd = Z + (size_t)b * TT * OD_IN + 1280 + h * 64; t.VTd = VTN + (size_t)(b * 8 + h) * 64 * TT; t.nd = CL;
            t.Y = Y + row * D + 512 + h * 64;
        }
        if (t.nb == 2) gqa_block(t.Q, t.Kd, t.VTd, t.nd, t.Y, (bf16_t*)(sRpb + 4096), tid, lane, a32);
        else if (t.nb == 1) { const int tk = task - 2048; const int b = tk >> 6, hg4 = (tk & 1) * 4;
            na_block(t.Q, Z + (size_t)b * TT * OD_IN + 1280 + hg4 * 64, VTN + (size_t)(b * 8 + hg4) * 64 * TT, t.r, wid >> 1, t.qc0, t.rpb, t.Y, (bf16_t*)(sRpb + 4096), tid, lane, a32); }
        else attn_wave(t, lane, a32);
    }
}

#define XB_TMO      128
#define XB_XCNT(j)  (256  + 64 * (j))
#define XB_XSUB(j)  (1280 + 64 * (j))
#define XB_XGEN(j)  (2304 + 64 * (j))
#define XB_TOP      3328
#define XB_TOPGEN   3392
#define XCD_BAR_WORDS 3456
#define XB_SPIN_CAP (1u << 22)
__device__ __forceinline__ unsigned xb_ld(unsigned* p)              { return __hip_atomic_load(p, __ATOMIC_RELAXED, __HIP_MEMORY_SCOPE_AGENT); }
__device__ __forceinline__ unsigned xb_add(unsigned* p, unsigned v) { return __hip_atomic_fetch_add(p, v, __ATOMIC_RELAXED, __HIP_MEMORY_SCOPE_AGENT); }
__device__ __forceinline__ unsigned xb_xcc_id() { return (unsigned)__builtin_amdgcn_s_getreg((3 << 11) | 20) & 0xFu; }
#define XB_SPIN(cond, bar) do { unsigned _sp = 0; while (cond) { __builtin_amdgcn_s_sleep(1); \
    if ((++_sp & 255u) == 0u) { if (xb_ld(&(bar)[XB_TMO])) break; if (_sp > XB_SPIN_CAP) { atomicAdd(&(bar)[XB_TMO], 1u); break; } } } } while (0)
__device__ __forceinline__ void xcd_barrier_complete(unsigned* bar, unsigned x, unsigned& nloc, unsigned& nx) {
    const unsigned G = gridDim.x;
    unsigned sum, cnt, mine, sp = 0u;
    for (;;) {
        sum = 0u; cnt = 0u; mine = 0u;
#pragma unroll
        for (unsigned j = 0; j < 16; ++j) { const unsigned c = xb_ld(&bar[XB_XCNT(j)]); sum += c; cnt += (c > 0u) ? 1u : 0u; mine = (j == x) ? c : mine; }
        if (sum == G) break;
        __builtin_amdgcn_s_sleep(1);
        if ((++sp & 255u) == 0u) { if (xb_ld(&bar[XB_TMO])) break; if (sp > XB_SPIN_CAP) { atomicAdd(&bar[XB_TMO], 1u); break; } }
    }
    nloc = mine > 0u ? mine : 1u; nx = cnt > 0u ? cnt : 1u;
}
__device__ __forceinline__ void gbar(unsigned* bar, volatile LAS unsigned* st) {
    asm volatile("s_waitcnt vmcnt(0)" ::: "memory");
    __syncthreads();
    if (threadIdx.x == 0) {
        __builtin_amdgcn_s_waitcnt(0);
        const unsigned x = xb_xcc_id();
        unsigned nloc = st[0], nx = st[1];
        if (nloc == 0u) { xcd_barrier_complete(bar, x, nloc, nx); st[0] = nloc; st[1] = nx; }
        const unsigned old = xb_add(&bar[XB_XSUB(x)], 1u);
        const unsigned gen = old / nloc;
        if (old + 1u == (gen + 1u) * nloc) {
            __builtin_amdgcn_fence(__ATOMIC_RELEASE, "agent");
            asm volatile("s_waitcnt vmcnt(0)" ::: "memory");
            const unsigned og = xb_add(&bar[XB_TOP], 1u);
            const unsigned tg = og / nx;
            if (og + 1u == (tg + 1u) * nx) xb_add(&bar[XB_TOPGEN], 1u);
            else XB_SPIN(xb_ld(&bar[XB_TOPGEN]) == tg, bar);
            __builtin_amdgcn_fence(__ATOMIC_ACQUIRE, "agent");
            xb_add(&bar[XB_XGEN(x)], 1u);
            asm volatile("s_waitcnt vmcnt(0)" ::: "memory");
        } else {
            XB_SPIN(xb_ld(&bar[XB_XGEN(x)]) == gen, bar);
            __builtin_amdgcn_fence(__ATOMIC_ACQUIRE, "agent");
            asm volatile("s_waitcnt vmcnt(0)" ::: "memory");
        }
    }
    __syncthreads();
}
constexpr size_t OFF_BAR = OFF_MOD + 3670016;
__global__ void __launch_bounds__(512, 2) mega(Params p) {
    extern __shared__ __attribute__((aligned(16))) unsigned char lds_raw[];
    cg::grid_group grid = cg::this_grid();
    float* smf = (float*)lds_raw;
    LAS unsigned char* ldsg = (LAS unsigned char*)lds_raw;
    if (blockIdx.x == 0) { unsigned* bw = (unsigned*)(wsp() + OFF_BAR); for (int i = threadIdx.x; i < XCD_BAR_WORDS; i += 512) __hip_atomic_store(bw + i, 0u, __ATOMIC_RELAXED, __HIP_MEMORY_SCOPE_AGENT); }
    volatile LAS unsigned* bar_st = (volatile LAS unsigned*)(ldsg + LDS_BYTES - 16);
    if (threadIdx.x == 0) { bar_st[0] = 0u; bar_st[1] = 0u; }
    for (int l = 0; l < 4; ++l) {
        const int j = l >> 1; unsigned char* wl = wsp() + OFF_W + (size_t)l * WL_BYTES;
        if ((l & 1) == 0) { convert_matrix(inp(10) + (size_t)j * D * EV_IN, D, EV_IN, EV_INP, 0, (bf16_t*)(wl + WO_IN), smf);
                            convert_matrix(inp(11) + (size_t)j * D * D, D, D, D, 0, (bf16_t*)(wl + WO_OUT), smf); }
        else              { convert_matrix(inp(26) + (size_t)j * D * OD_IN, D, OD_IN, OD_IN, 0, (bf16_t*)(wl + WO_IN), smf);
                            convert_matrix(inp(27) + (size_t)j * D * D, D, D, D, 0, (bf16_t*)(wl + WO_OUT), smf); }
        convert_matrix(inp(8) + (size_t)l * D * NFF, D, NFF, NFF, 1, (bf16_t*)(wl + WO_W13), smf);
        convert_matrix(inp(9) + (size_t)l * DFF * D, DFF, D, D, 0, (bf16_t*)(wl + WO_W2), smf);
    }
    { const int b0_ = bid_(), gd_ = gdim_(); for (int item = b0_; item < 192; item += gd_) mod_item(p, item, smf, smf + 33 * 256); }
    grid.sync();
    if (threadIdx.x == 0) (void)xb_add(&((unsigned*)(wsp() + OFF_BAR))[XB_XCNT(xb_xcc_id())], 1u);

#define WS_ (wsp())
#define MODL_ ((const float*)(WS_ + OFF_MOD) + (size_t)l * 33 * 6144)
#define WL_ (WS_ + OFF_W + (size_t)l * WL_BYTES)
#define HB_ ((bf16_t*)(WS_ + OFF_H))
#define CTXX_ ((float*)(WS_ + OFF_CTXX))
    for (int l = 0; l < 4; ++l) {
        const int j = l >> 1; const bool even = (l & 1) == 0;
        norm_phase((l == 0) ? inp(0) : (const float*)outp(), (l == 0) ? inp(2) : (const float*)CTXX_, inp(6) + l * D, MODL_, 0, 1024, HB_);
        gbar((unsigned*)(wsp() + OFF_BAR), bar_st);
        if (even) {
            for (int hb = 0; hb < 2; ++hb) {
                { unsigned char* R = WS_ + OFF_R;
                  pg8::Gemm g{HB_ + (size_t)hb * HROWS * D, (const bf16_t*)(WL_ + WO_IN), HROWS, EV_INP, D};
                  pg8::StaticOrder S; S.init(HROWS, EV_INP, gdim_(), bid_());
                  EpiZ E{(bf16_t*)R, EV_INP};
                  pg8::gemm_phase<EpiZ>(ldsg, g, S, E); }
                gbar((unsigned*)(wsp() + OFF_BAR), bar_st);
                for (int rep_ = 0; rep_ < REP_FEAT; ++rep_) { unsigned char* R = WS_ + OFF_R; even_feat_phase(p, j, (const bf16_t*)R, (bf16_t*)(R + RO_F), smf); }
                gbar((unsigned*)(wsp() + OFF_BAR), bar_st);
                for (int rep_ = 0; rep_ < REP_RWKV; ++rep_) { unsigned char* R = WS_ + OFF_R; rwkv_scan_phase((const bf16_t*)(R + RO_F), (bf16_t*)(R + RO_O), smf); }
                for (int rep_ = 0; rep_ < REP_GLA; ++rep_) { unsigned char* R = WS_ + OFF_R; gla_phase(p, j, (const bf16_t*)R, (bf16_t*)(R + RO_O), smf); }
                gbar((unsigned*)(wsp() + OFF_BAR), bar_st);
                { unsigned char* R = WS_ + OFF_R; even_merge_phase(p, j, (const bf16_t*)R, (const bf16_t*)(R + RO_F), (const bf16_t*)(R + RO_O), HB_ + (size_t)hb * HROWS * D); }
                gbar((unsigned*)(wsp() + OFF_BAR), bar_st);
            }
        } else {
            { unsigned char* R = WS_ + OFF_R;
              pg8::Gemm g{HB_, (const bf16_t*)(WL_ + WO_IN), MROWS, OD_IN, D};
              pg8::StaticOrder S; S.init(MROWS, OD_IN, gdim_(), bid_());
              EpiZ E{(bf16_t*)R, OD_IN};
              pg8::gemm_phase<EpiZ>(ldsg, g, S, E); }
            gbar((unsigned*)(wsp() + OFF_BAR), bar_st);
            { unsigned char* R = WS_ + OFF_R; odd_feat_phase(p, j, (bf16_t*)R, (bf16_t*)(R + RO_VTG), (bf16_t*)(R + RO_VTN), smf); }
            gbar((unsigned*)(wsp() + OFF_BAR), bar_st);
            for (int rep_ = 0; rep_ < REP_ATTN; ++rep_) { unsigned char* R = WS_ + OFF_R; odd_attn_phase(p, j, l < 3, (const bf16_t*)R, (const bf16_t*)(R + RO_VTG), (const bf16_t*)(R + RO_VTN), HB_, smf); }
            gbar((unsigned*)(wsp() + OFF_BAR), bar_st);
        }
        { pg8::Gemm g{HB_, (const bf16_t*)(WL_ + WO_OUT), MROWS, D, D};
          pg8::StaticOrder S; S.init(MROWS, D, gdim_(), bid_(), l == 3);
          EpiRes E{(l == 0) ? inp(0) : (const float*)outp(), (l == 0) ? inp(2) : (const float*)CTXX_, outp(), CTXX_, MODL_, 2048};
          pg8::gemm_phase<EpiRes>(ldsg, g, S, E); }
        gbar((unsigned*)(wsp() + OFF_BAR), bar_st);
        norm_phase(outp(), CTXX_, inp(7) + l * D, MODL_, 3072, 4096, HB_);
        gbar((unsigned*)(wsp() + OFF_BAR), bar_st);
        for (int rep_ = 0; rep_ < REP_FFNUP; ++rep_) { pg8::Gemm g{HB_, (const bf16_t*)(WL_ + WO_W13), MROWS, NFF, D};
          pg8::StaticOrder S; S.init(MROWS, NFF, gdim_(), bid_(), l == 3);
          EpiSwi E{(bf16_t*)(WS_ + OFF_R)};
          pg8::gemm_phase<EpiSwi>(ldsg, g, S, E); }
        gbar((unsigned*)(wsp() + OFF_BAR), bar_st);
        { pg8::Gemm g{(const bf16_t*)(WS_ + OFF_R), (const bf16_t*)(WL_ + WO_W2), MROWS, D, DFF};
          pg8::StaticOrder S; S.init(MROWS, D, gdim_(), bid_(), l == 3);
          EpiRes E{outp(), CTXX_, outp(), CTXX_, MODL_, 5120};
          pg8::gemm_phase<EpiRes>(ldsg, g, S, E); }
        gbar((unsigned*)(wsp() + OFF_BAR), bar_st);
    }
    float* xfin = outp(); const float* gfin = inp(31);
    const int tid = tid_(), lane = tid & 63, gw = bid_() * 8 + (tid >> 6), nw = gdim_() * 8; const int a32 = x32addr_();
    for (int r4 = gw; r4 < NB * TL / 4; r4 += nw) {
        float* xr = xfin + (size_t)r4 * 4 * D;
        f32x4 v[4][4];
#pragma unroll
        for (int rr = 0; rr < 4; ++rr)
#pragma unroll
            for (int i = 0; i < 4; ++i) v[rr][i] = *(const f32x4*)(xr + (size_t)rr * D + i * 256 + lane * 4);
        f32x4 gg[4];
#pragma unroll
        for (int i = 0; i < 4; ++i) gg[i] = *(const f32x4*)(gfin + i * 256 + lane * 4);
#pragma unroll
        for (int rr = 0; rr < 4; ++rr) {
            float ss = 0.f;
#pragma unroll
            for (int i = 0; i < 4; ++i) ss += v[rr][i][0] * v[rr][i][0] + v[rr][i][1] * v[rr][i][1] + v[rr][i][2] * v[rr][i][2] + v[rr][i][3] * v[rr][i][3];
            ss = red64(ss, a32);
            const float rs = rsqrtf(ss * (1.0f / 1024.0f) + 1e-6f);
#pragma unroll
            for (int i = 0; i < 4; ++i) *(f32x4*)(xr + (size_t)rr * D + i * 256 + lane * 4) = v[rr][i] * rs * gg[i];
        }
    }
}

extern "C" void kernel_launch(void* const* d_in, const int* in_sizes, int n_in, void* d_out, int out_size, void* d_ws, size_t ws_size, hipStream_t stream) {
    static int grid_blocks = 0;
    if (!grid_blocks) {
        int dev = 0, cus = 0, per_cu = 0;
        (void)hipGetDevice(&dev);
        (void)hipDeviceGetAttribute(&cus, hipDeviceAttributeMultiprocessorCount, dev);
        (void)hipFuncSetAttribute((const void*)mega, hipFuncAttributeMaxDynamicSharedMemorySize, LDS_BYTES);
        (void)hipOccupancyMaxActiveBlocksPerMultiprocessor(&per_cu, (const void*)mega, 512, LDS_BYTES);
        if (per_cu < 1) per_cu = 1;
        grid_blocks = cus * per_cu;
        if (ws_size < WS_NEED || n_in != 32) { fprintf(stderr, "kernel_launch: workspace %zu < %zu or n_in %d != 32\n", ws_size, (size_t)WS_NEED, n_in); grid_blocks = -1; }
    }
    if (grid_blocks < 0) return;
    Params p{};
    for (int i = 0; i < 32; ++i) p.in[i] = (const float*)d_in[i];
    p.out = (float*)d_out; p.ws = (unsigned char*)d_ws;
    void* args[] = {&p};
    hipError_t e = hipLaunchCooperativeKernel((void*)mega, dim3(grid_blocks), dim3(512), args, LDS_BYTES, stream);
    if (e != hipSuccess) fprintf(stderr, "cooperative launch failed: %s (grid %d)\n", hipGetErrorString(e), grid_blocks);
}
```
